# Optimizing an MI355X kernel written in HIP

```python
import math
import jax, jax.numpy as jnp
from jax import lax
import numpy as np

D_MODEL = 1024
BATCH = 2
SEQ = 8192
DEPTH = 2

RET_WIDTH = D_MODEL // 2
RET_HEAD_DIM = 64
RET_HEADS = RET_WIDTH // RET_HEAD_DIM
DIFF_WIDTH = D_MODEL - RET_WIDTH
DIFF_HEAD_DIM = 64
DIFF_V_DIM = 2 * DIFF_HEAD_DIM
DIFF_HEADS = DIFF_WIDTH // DIFF_V_DIM
MIX_WIDTH = RET_WIDTH + DIFF_WIDTH
D_IN_PROJ = 4 * RET_WIDTH + 3 * DIFF_WIDTH
D_FF = -(-8 * D_MODEL // (3 * 256)) * 256
CHUNK = 128
Q_BLOCK = 128
EPS = 1e-6

kernel_name = "hybrid_retention_diffattn_encoder"


def rms_norm(x, g):
    xf = x.astype(jnp.float32)
    y = xf * lax.rsqrt(jnp.mean(xf * xf, axis=-1, keepdims=True) + EPS)
    return (y * g.astype(jnp.float32)).astype(x.dtype)


def alibi_slopes(n):
    return 2.0 ** (-8.0 * jnp.arange(1, n + 1, dtype=jnp.float32) / n)


def retention_bidir(q, k, v, lg_f, lg_b):
    B, S, H, D = q.shape
    N = S // CHUNK
    qc = q.astype(jnp.float32).reshape(B, N, CHUNK, H, D)
    kc = k.astype(jnp.float32).reshape(B, N, CHUNK, H, D)
    vc = v.astype(jnp.float32).reshape(B, N, CHUNK, H, D)
    pos = jnp.arange(CHUNK, dtype=jnp.float32)
    dist = pos[:, None] - pos[None, :]
    mask_f = jnp.where(dist >= 0, jnp.exp(lg_f[:, None, None] * jnp.maximum(dist, 0.0)), 0.0)
    mask_b = jnp.where(dist < 0, jnp.exp(lg_b[:, None, None] * jnp.maximum(-dist, 0.0)), 0.0)
    dmask = mask_f + mask_b
    scores = jnp.einsum('bnthd,bnshd->bnhts', qc, kc) * dmask[None, None]
    intra = jnp.einsum('bnhts,bnshd->bnthd', scores, vc)

    wk_f = jnp.exp(lg_f[None, :] * (CHUNK - 1 - pos)[:, None])
    wq_f = jnp.exp(lg_f[None, :] * (pos + 1)[:, None])
    kv_f = jnp.einsum('bnshd,bnshe->nbhde', kc * wk_f[None, None, :, :, None], vc)
    dc_f = jnp.exp(lg_f * CHUNK)[None, :, None, None]
    wk_b = jnp.exp(lg_b[None, :] * pos[:, None])
    wq_b = jnp.exp(lg_b[None, :] * (CHUNK - pos)[:, None])
    kv_b = jnp.einsum('bnshd,bnshe->nbhde', kc * wk_b[None, None, :, :, None], vc)
    dc_b = jnp.exp(lg_b * CHUNK)[None, :, None, None]

    zeros = jnp.zeros((B, H, D, D), jnp.float32)

    def fwd_step(R, kv):
        return dc_f * R + kv, R

    def bwd_step(R, kv):
        return dc_b * R + kv, R

    _, R_f = lax.scan(fwd_step, zeros, kv_f)
    _, R_b = lax.scan(bwd_step, zeros, kv_b, reverse=True)
    cross_f = jnp.einsum('bnthd,nbhde->bnthe', qc * wq_f[None, None, :, :, None], R_f)
    cross_b = jnp.einsum('bnthd,nbhde->bnthe', qc * wq_b[None, None, :, :, None], R_b)
    out = (intra + cross_f + cross_b).reshape(B, S, H, D)
    return out.astype(q.dtype)


def diff_attention(q, k, v, lam, slopes):
    B, S, H, _, Dh = q.shape
    NB = S // Q_BLOCK
    q_blocks = q.reshape(B, NB, Q_BLOCK, H, 2, Dh).transpose(1, 0, 2, 3, 4, 5)
    starts = jnp.arange(NB, dtype=jnp.int32) * Q_BLOCK
    kpos = jnp.arange(S, dtype=jnp.int32)
    vf = v.astype(jnp.float32)

    def block(args):
        qb, start = args
        s = jnp.einsum('bqhmd,bkhmd->bhmqk', qb, k).astype(jnp.float32)
        qpos = start + jnp.arange(Q_BLOCK, dtype=jnp.int32)
        dist = jnp.abs(qpos[:, None] - kpos[None, :]).astype(jnp.float32)
        s = s - slopes[None, :, None, None, None] * dist[None, None, None]
        p = jax.nn.softmax(s, axis=-1)
        a = p[:, :, 0] - lam * p[:, :, 1]
        return jnp.einsum('bhqk,bkhe->bqhe', a, vf)

    o = lax.map(block, (q_blocks, starts))
    return o.transpose(1, 0, 2, 3, 4).reshape(B, S, H, DIFF_V_DIM).astype(q.dtype)


def setup_inputs(seed: int = 0) -> dict:
    key = jax.random.key(seed)
    ks = jax.random.split(key, 20)
    f32 = jnp.float32
    nrm = lambda k, shape, scale: jax.random.normal(k, shape, f32) * scale
    heads = jnp.arange(RET_HEADS, dtype=f32)
    base = jnp.log(-jnp.log1p(-(2.0 ** (-5.0 - heads))))
    return {
        "x": jax.random.normal(ks[0], (BATCH, SEQ, D_MODEL), f32),
        "attn_norm_g": 1.0 + nrm(ks[1], (DEPTH, D_MODEL), 0.02),
        "w_in": nrm(ks[2], (DEPTH, D_MODEL, D_IN_PROJ), D_MODEL ** -0.5),
        "ret_decay_fwd": base[None, :] + nrm(ks[3], (DEPTH, RET_HEADS), 0.1),
        "ret_decay_bwd": base[None, :] + nrm(ks[4], (DEPTH, RET_HEADS), 0.1),
        "ret_norm_g": 1.0 + nrm(ks[5], (DEPTH, RET_HEAD_DIM), 0.02),
        "dq_norm_g": 1.0 + nrm(ks[6], (DEPTH, DIFF_HEAD_DIM), 0.02),
        "dk_norm_g": 1.0 + nrm(ks[7], (DEPTH, DIFF_HEAD_DIM), 0.02),
        "lambda_q1": nrm(ks[8], (DEPTH, DIFF_HEAD_DIM), 0.1),
        "lambda_k1": nrm(ks[9], (DEPTH, DIFF_HEAD_DIM), 0.1),
        "lambda_q2": nrm(ks[10], (DEPTH, DIFF_HEAD_DIM), 0.1),
        "lambda_k2": nrm(ks[11], (DEPTH, DIFF_HEAD_DIM), 0.1),
        "diff_norm_g": 1.0 + nrm(ks[12], (DEPTH, DIFF_V_DIM), 0.02),
        "w_out": nrm(ks[13], (DEPTH, MIX_WIDTH, D_MODEL), MIX_WIDTH ** -0.5),
        "ffn_norm_g": 1.0 + nrm(ks[14], (DEPTH, D_MODEL), 0.02),
        "w_gate": nrm(ks[15], (DEPTH, D_MODEL, D_FF), D_MODEL ** -0.5),
        "w_up": nrm(ks[16], (DEPTH, D_MODEL, D_FF), D_MODEL ** -0.5),
        "w_down": nrm(ks[17], (DEPTH, D_FF, D_MODEL), D_FF ** -0.5),
    }


def reference(x, attn_norm_g, w_in, ret_decay_fwd, ret_decay_bwd, ret_norm_g,
              dq_norm_g, dk_norm_g, lambda_q1, lambda_k1, lambda_q2, lambda_k2,
              diff_norm_g, w_out, ffn_norm_g, w_gate, w_up, w_down):
    B, S, _ = x.shape
    slopes = alibi_slopes(DIFF_HEADS)
    split_at = [RET_WIDTH, 2 * RET_WIDTH, 3 * RET_WIDTH, 4 * RET_WIDTH,
                4 * RET_WIDTH + DIFF_WIDTH, 4 * RET_WIDTH + 2 * DIFF_WIDTH]
    for l in range(DEPTH):
        lam_init = 0.8 - 0.6 * math.exp(-0.3 * l)
        h = rms_norm(x, attn_norm_g[l])
        proj = h @ w_in[l]
        rq, rk, rv, rg, dq, dk, dv = jnp.split(proj, split_at, axis=-1)

        shp = (B, S, RET_HEADS, RET_HEAD_DIM)
        lg_f = -jnp.exp(ret_decay_fwd[l].astype(jnp.float32))
        lg_b = -jnp.exp(ret_decay_bwd[l].astype(jnp.float32))
        ret = retention_bidir(rq.reshape(shp), rk.reshape(shp) * RET_HEAD_DIM ** -0.5,
                              rv.reshape(shp), lg_f, lg_b)
        ret = rms_norm(ret, ret_norm_g[l]) * jax.nn.silu(rg.reshape(shp))
        ret = ret.reshape(B, S, RET_WIDTH)

        qk_shp = (B, S, DIFF_HEADS, 2, DIFF_HEAD_DIM)
        dqn = rms_norm(dq.reshape(qk_shp), dq_norm_g[l]) * DIFF_HEAD_DIM ** -0.5
        dkn = rms_norm(dk.reshape(qk_shp), dk_norm_g[l])
        lam = (jnp.exp(jnp.sum(lambda_q1[l].astype(jnp.float32) * lambda_k1[l].astype(jnp.float32)))
               - jnp.exp(jnp.sum(lambda_q2[l].astype(jnp.float32) * lambda_k2[l].astype(jnp.float32)))
               + lam_init)
        da = diff_attention(dqn, dkn, dv.reshape(B, S, DIFF_HEADS, DIFF_V_DIM), lam, slopes)
        da = (rms_norm(da, diff_norm_g[l]) * (1.0 - lam_init)).reshape(B, S, DIFF_WIDTH)

        x = x + jnp.concatenate([ret, da], axis=-1) @ w_out[l]

        h = rms_norm(x, ffn_norm_g[l])
        x = x + (jax.nn.silu(h @ w_gate[l]) * (h @ w_up[l])) @ w_down[l]
    return x
```

```cpp
#include <hip/hip_runtime.h>
#include <hip/hip_cooperative_groups.h>
#include <cstdio>
#include <cstdint>
namespace cg = cooperative_groups;
namespace pg8 {
#define PG8_LAS __attribute__((address_space(3)))
typedef unsigned short bf16_t;
typedef short bf16x8 __attribute__((ext_vector_type(8)));
typedef float f32x4 __attribute__((ext_vector_type(4)));
typedef unsigned u32x4 __attribute__((ext_vector_type(4)));
constexpr int BM = 256, BK = 64, HALF = 128, HTB = HALF * BK * 2  , STAGE_BYTES = 8 * HTB, NXCD = 8, WGM = 8;

__host__ __device__ __forceinline__ int lds_byte(int r, int c) { const int st = (r >> 4) * 2 + (c >> 5), rr = r & 15, cc = c & 31, ob = rr * 64 + cc * 2; return st * 1024 + (ob ^ (((ob >> 9) & 1) << 5)); }
__host__ __device__ __forceinline__ void stage_rc(int b, int& R, int& C) { const int st = b / 1024, sb = b % 1024, swz = sb ^ (((sb >> 9) & 1) << 5); R = (st >> 1) * 16 + swz / 64; C = (st & 1) * 32 + (swz % 64) / 2; }
__host__ __device__ __forceinline__ int perm32(int rho) { const int n = rho >> 4, i = rho & 15; return 8 * (i >> 2) + 4 * n + (i & 3); }

struct Unit { int pm, pn; };
struct Gemm { const bf16_t* A; const bf16_t* Bt; int M, N, K; };

struct StaticOrder {
    int nM, nN, nwg, G, c;
    __host__ __device__ void init(int M, int N, int G_, int c_) { nM = M / BM; nN = N / BM; nwg = nM * nN; G = G_; c = c_; }
    __host__ __device__ bool next(int i, Unit& u) const {
        const long L = (long)i * G + c; if (L >= nwg) return false;
        int wgid = (int)L; { const int q = nwg / NXCD, r = nwg % NXCD, xcd = wgid % NXCD, off = wgid / NXCD; wgid = (xcd < r ? xcd * (q + 1) : r * (q + 1) + (xcd - r) * q) + off; }
        const int nig = WGM * nN, gid = wgid / nig, fm = gid * WGM, gsz = (nM - fm) < WGM ? (nM - fm) : WGM;
        u.pm = fm + ((wgid % nig) % gsz); u.pn = (wgid % nig) / gsz; return true;
    }
    __device__ __forceinline__ void a_ready(const Unit&) const {}
    __device__ __forceinline__ void done(const Unit&) const {}
};

__device__ __forceinline__ unsigned cvt_pk_bf16(float lo, float hi) { unsigned r; asm volatile("v_cvt_pk_bf16_f32 %0, %1, %2" : "=v"(r) : "v"(lo), "v"(hi)); return r; }
typedef float f32x2 __attribute__((ext_vector_type(2)));
typedef unsigned u32x2 __attribute__((ext_vector_type(2)));
constexpr float RMS_EPS = 1e-6f;
struct EpiProj {
    static constexpr bool PERM = true, AFTER_DRAIN = false;
    bf16_t* O; int ldc; const float* ssq;
    __device__ __forceinline__ void operator()(const f32x4 (&acc)[2][2][4][2], const Unit& u, int wr, int wc, int fr, int fq) const {
        const int row0 = u.pm * BM + wr * 64 + fr, col0 = u.pn * BM + wc * 32 + 8 * fq;
#pragma unroll
        for (int ai = 0; ai < 2; ++ai)
#pragma unroll
            for (int m = 0; m < 4; ++m) { const int row = row0 + ai * HALF + m * 16; const float rs = __builtin_amdgcn_rsqf(ssq[row] * (1.0f / 1024.0f) + RMS_EPS);
                bf16_t* rowp = O + (size_t)row * ldc + col0;
#pragma unroll
                for (int bj = 0; bj < 2; ++bj) { const f32x4 v0 = acc[ai][bj][m][0] * rs, v1 = acc[ai][bj][m][1] * rs;
                    u32x4 w; w.x = cvt_pk_bf16(v0[0], v0[1]); w.y = cvt_pk_bf16(v0[2], v0[3]); w.z = cvt_pk_bf16(v1[0], v1[1]); w.w = cvt_pk_bf16(v1[2], v1[3]);
                    *(u32x4*)(rowp + bj * HALF) = w; } }
    }
};
struct EpiSwiglu {
    static constexpr bool PERM = true, AFTER_DRAIN = false;
    bf16_t* O; int ldc; const float* ssq;
    __device__ __forceinline__ void operator()(const f32x4 (&acc)[2][2][4][2], const Unit& u, int wr, int wc, int fr, int fq) const {
        const int row0 = u.pm * BM + wr * 64 + fr, col0 = u.pn * HALF + wc * 32 + 8 * fq;
#pragma unroll
        for (int ai = 0; ai < 2; ++ai)
#pragma unroll
            for (int m = 0; m < 4; ++m) { const int row = row0 + ai * HALF + m * 16; const float rs = __builtin_amdgcn_rsqf(ssq[row] * (1.0f / 1024.0f) + RMS_EPS);
                float hv[8];
#pragma unroll
                for (int n = 0; n < 2; ++n)
#pragma unroll
                    for (int j = 0; j < 4; ++j) { const float g = acc[ai][0][m][n][j] * rs, up = acc[ai][1][m][n][j] * rs;
                        const float sg = g * __builtin_amdgcn_rcpf(1.0f + __builtin_amdgcn_exp2f(-1.4426950408889634f * g)); hv[n * 4 + j] = sg * up; }
                u32x4 w; w.x = cvt_pk_bf16(hv[0], hv[1]); w.y = cvt_pk_bf16(hv[2], hv[3]); w.z = cvt_pk_bf16(hv[4], hv[5]); w.w = cvt_pk_bf16(hv[6], hv[7]);
                *(u32x4*)(O + (size_t)row * ldc + col0) = w; }
    }
};
struct EpiRes {
    static constexpr bool PERM = true, AFTER_DRAIN = false;
    bf16_t* xb; float* out; float* ssq;
    __device__ __forceinline__ void operator()(const f32x4 (&acc)[2][2][4][2], const Unit& u, int wr, int wc, int fr, int fq) const {
        const int row0 = u.pm * BM + wr * 64 + fr, col0 = u.pn * BM + wc * 32 + 8 * fq;
#pragma unroll
        for (int ai = 0; ai < 2; ++ai)
#pragma unroll
            for (int m = 0; m < 4; ++m) { const int row = row0 + ai * HALF + m * 16; const size_t off = (size_t)row * 1024 + col0; float part = 0.f;
#pragma unroll
                for (int bj = 0; bj < 2; ++bj) { const size_t o = off + bj * HALF; const u32x4 rb = *(const u32x4*)(xb + o);
                    f32x4 v0, v1;
                    v0[0] = __uint_as_float(rb.x << 16) + acc[ai][bj][m][0][0]; v0[1] = __uint_as_float(rb.x & 0xffff0000u) + acc[ai][bj][m][0][1];
                    v0[2] = __uint_as_float(rb.y << 16) + acc[ai][bj][m][0][2]; v0[3] = __uint_as_float(rb.y & 0xffff0000u) + acc[ai][bj][m][0][3];
                    v1[0] = __uint_as_float(rb.z << 16) + acc[ai][bj][m][1][0]; v1[1] = __uint_as_float(rb.z & 0xffff0000u) + acc[ai][bj][m][1][1];
                    v1[2] = __uint_as_float(rb.w << 16) + acc[ai][bj][m][1][2]; v1[3] = __uint_as_float(rb.w & 0xffff0000u) + acc[ai][bj][m][1][3];
                    if (out) { *(f32x4*)(out + o) = v0; *(f32x4*)(out + o + 4) = v1; }
                    else { part += ((v0[0] * v0[0] + v0[1] * v0[1]) + (v0[2] * v0[2] + v0[3] * v0[3])) + ((v1[0] * v1[0] + v1[1] * v1[1]) + (v1[2] * v1[2] + v1[3] * v1[3]));
                        u32x4 w; w.x = cvt_pk_bf16(v0[0], v0[1]); w.y = cvt_pk_bf16(v0[2], v0[3]); w.z = cvt_pk_bf16(v1[0], v1[1]); w.w = cvt_pk_bf16(v1[2], v1[3]); *(u32x4*)(xb + o) = w; } }
                if (!out) { part += __shfl_xor(part, 16); part += __shfl_xor(part, 32);
                    if (fq == 0) __hip_atomic_fetch_add(ssq + row, part, __ATOMIC_RELAXED, __HIP_MEMORY_SCOPE_AGENT); } }
    }
};
template <class Epi, class Sched, bool ALIGN_EPI = false, bool SP2 = false>
__device__ __forceinline__ void gemm_phase(PG8_LAS unsigned char* lds, const Gemm g, const Sched& S, const Epi& E, const int tid_in) {
    const int tid = tid_in, wid = __builtin_amdgcn_readfirstlane(tid >> 6), lane = tid & 63, wr = wid >> 2, wc = wid & 3, fr = lane & 15, fq = lane >> 4;
    const int K = g.K, nt = K / BK;
    unsigned voffA[2], voffB[2];
#pragma unroll
    for (int i = 0; i < 2; ++i) { int R, C; stage_rc(tid * 16 + i * 8192, R, C); const int Rb = Epi::PERM ? ((R & ~31) + perm32(R & 31)) : R;
        voffA[i] = (unsigned)(R * K + C) * 2u; voffB[i] = (unsigned)(Rb * K + C) * 2u; }
    const size_t kstep = (size_t)(BK * 2);
    const size_t hstep = (size_t)HALF * K * 2;
    const size_t tstep = 2 * hstep;
    const unsigned ldsw = (unsigned)wid * 1024u;
    const int aoff = lds_byte(wr * 64 + fr, fq * 8), boff = lds_byte(wc * 32 + fr, fq * 8);
#define PG8_SA(b, h) (((b) * 2 + (h)) * HTB)
#define PG8_SB(b, h) ((4 + (b) * 2 + (h)) * HTB)
#define PG8_STAGE(bufoff, gbase, voff) do { _Pragma("unroll") for (int _i = 0; _i < 2; ++_i) \
        __builtin_amdgcn_global_load_lds((const unsigned*)((const char*)(gbase) + (voff)[_i]), (PG8_LAS unsigned*)(lds + (bufoff) + ldsw + _i * 8192), 16, 0, 0); } while (0)
#define PG8_LDA(dst, b, h) do { _Pragma("unroll") for (int m = 0; m < 4; ++m) _Pragma("unroll") for (int k = 0; k < 2; ++k) dst[m][k] = *(const PG8_LAS bf16x8*)(lds + PG8_SA(b, h) + aoff + m * 2048 + k * 1024); } while (0)
#define PG8_LDB(dst, b, h) do { _Pragma("unroll") for (int n = 0; n < 2; ++n) _Pragma("unroll") for (int k = 0; k < 2; ++k) dst[n][k] = *(const PG8_LAS bf16x8*)(lds + PG8_SB(b, h) + boff + n * 2048 + k * 1024); } while (0)
#define PG8_MMA(ai, bj, At, Bt) do { __builtin_amdgcn_s_setprio(1); _Pragma("unroll") for (int m = 0; m < 4; ++m) _Pragma("unroll") for (int n = 0; n < 2; ++n) _Pragma("unroll") for (int k = 0; k < 2; ++k) \
        acc[ai][bj][m][n] = __builtin_amdgcn_mfma_f32_16x16x32_bf16(Bt[n][k], At[m][k], acc[ai][bj][m][n], 0, 0, 0); __builtin_amdgcn_s_setprio(0); } while (0)
#define PG8_WAIT_V(n) asm volatile("s_waitcnt vmcnt(" #n ")" ::: "memory")
#define PG8_WAIT_L(n) asm volatile("s_waitcnt lgkmcnt(" #n ")" ::: "memory")
#define PG8_BAR __builtin_amdgcn_s_barrier()
#define PG8_SCHED __builtin_amdgcn_sched_barrier(0)
    Unit cur, nxt; int ui = 0;
    if (!S.next(0, cur)) return;
    f32x4 acc[2][2][4][2];
#pragma unroll
    for (int a = 0; a < 2; ++a)
#pragma unroll
        for (int b = 0; b < 2; ++b)
#pragma unroll
            for (int m = 0; m < 4; ++m)
#pragma unroll
                for (int n = 0; n < 2; ++n) acc[a][b][m][n] = (f32x4){0.f, 0.f, 0.f, 0.f};
    bf16x8 At[4][2], B0[2][2], B1[2][2];
    const char* cA = (const char*)g.A + (size_t)cur.pm * tstep; const char* cB = (const char*)g.Bt + (size_t)cur.pn * tstep;
    S.a_ready(cur);
    if constexpr (SP2) {
        PG8_STAGE(PG8_SB(0, 0), cB, voffB); PG8_STAGE(PG8_SB(0, 1), cB + hstep, voffB); PG8_STAGE(PG8_SA(0, 0), cA, voffA); PG8_STAGE(PG8_SA(0, 1), cA + hstep, voffA);
        if (wr == 1) PG8_BAR;
        PG8_WAIT_V(2); PG8_BAR;
        PG8_STAGE(PG8_SB(1, 0), cB + kstep, voffB); PG8_STAGE(PG8_SA(1, 0), cA + kstep, voffA); PG8_STAGE(PG8_SB(1, 1), cB + hstep + kstep, voffB);
        PG8_WAIT_V(6); PG8_BAR;
    } else {
        PG8_STAGE(PG8_SB(0, 0), cB, voffB); PG8_STAGE(PG8_SA(0, 0), cA, voffA); PG8_STAGE(PG8_SB(0, 1), cB + hstep, voffB); PG8_STAGE(PG8_SA(0, 1), cA + hstep, voffA);
        if (wr == 1) PG8_BAR;
        PG8_WAIT_V(4); PG8_BAR;
        PG8_STAGE(PG8_SB(1, 0), cB + kstep, voffB); PG8_STAGE(PG8_SA(1, 0), cA + kstep, voffA); PG8_STAGE(PG8_SB(1, 1), cB + hstep + kstep, voffB);
        PG8_WAIT_V(6); PG8_BAR;
    }
    for (;;) {
        const bool has_next = S.next(ui + 1, nxt);
        const char* nA = has_next ? (const char*)g.A + (size_t)nxt.pm * tstep : cA; const char* nB = has_next ? (const char*)g.Bt + (size_t)nxt.pn * tstep : cB;
        for (int t = 0; t < nt; t += 2) {
            const bool last = (t == nt - 2);
            const char* a1 = cA + (size_t)(t + 1) * kstep;
            const char* a2 = last ? nA : cA + (size_t)(t + 2) * kstep; const char* b2 = last ? nB : cB + (size_t)(t + 2) * kstep;
            const char* a3 = a2 + kstep; const char* b3 = b2 + kstep;
            if (last && has_next) S.a_ready(nxt);
            if constexpr (SP2) {
            PG8_LDB(B0, 0, 0); PG8_LDB(B1, 0, 1); PG8_SCHED; PG8_LDA(At, 0, 0); PG8_STAGE(PG8_SA(1, 1), a1 + hstep, voffA);
            PG8_WAIT_V(8); PG8_WAIT_L(0); PG8_BAR; PG8_MMA(0, 0, At, B0); PG8_MMA(0, 1, At, B1); PG8_BAR; PG8_SCHED;
            PG8_LDA(At, 0, 1); PG8_STAGE(PG8_SB(0, 0), b2, voffB); PG8_STAGE(PG8_SB(0, 1), b2 + hstep, voffB); PG8_STAGE(PG8_SA(0, 0), a2, voffA);
            PG8_WAIT_V(8); PG8_WAIT_L(0); PG8_BAR; PG8_MMA(1, 0, At, B0); PG8_MMA(1, 1, At, B1); PG8_BAR; PG8_SCHED;
            PG8_LDB(B0, 1, 0); PG8_LDB(B1, 1, 1); PG8_SCHED; PG8_LDA(At, 1, 0); PG8_STAGE(PG8_SA(0, 1), a2 + hstep, voffA);
            PG8_WAIT_V(8); PG8_WAIT_L(0); PG8_BAR; PG8_MMA(0, 0, At, B0); PG8_MMA(0, 1, At, B1); PG8_BAR; PG8_SCHED;
            PG8_LDA(At, 1, 1); PG8_STAGE(PG8_SB(1, 0), b3, voffB); PG8_STAGE(PG8_SB(1, 1), b3 + hstep, voffB); PG8_STAGE(PG8_SA(1, 0), a3, voffA);
            PG8_WAIT_V(8); PG8_WAIT_L(0); PG8_BAR; PG8_MMA(1, 0, At, B0); PG8_MMA(1, 1, At, B1); PG8_BAR; PG8_SCHED;
            } else {
            PG8_LDB(B0, 0, 0); PG8_SCHED; PG8_LDA(At, 0, 0); PG8_STAGE(PG8_SA(1, 1), a1 + hstep, voffA);
            PG8_WAIT_L(8); PG8_BAR; PG8_WAIT_L(0); PG8_MMA(0, 0, At, B0); PG8_BAR; PG8_SCHED;
            PG8_LDB(B1, 0, 1); PG8_STAGE(PG8_SB(0, 0), b2, voffB);
            PG8_BAR; PG8_WAIT_L(0); PG8_MMA(0, 1, At, B1); PG8_BAR;
            PG8_LDA(At, 0, 1); PG8_STAGE(PG8_SA(0, 0), a2, voffA);
            PG8_BAR; PG8_WAIT_L(0); PG8_MMA(1, 0, At, B0); PG8_BAR; PG8_SCHED;
            PG8_STAGE(PG8_SB(0, 1), b2 + hstep, voffB);
            PG8_WAIT_V(6); PG8_BAR; PG8_MMA(1, 1, At, B1); PG8_BAR;
            PG8_LDB(B0, 1, 0); PG8_SCHED; PG8_LDA(At, 1, 0); PG8_STAGE(PG8_SA(0, 1), a2 + hstep, voffA);
            PG8_WAIT_L(8); PG8_BAR; PG8_WAIT_L(0); PG8_MMA(0, 0, At, B0); PG8_BAR; PG8_SCHED;
            PG8_LDB(B1, 1, 1); PG8_STAGE(PG8_SB(1, 0), b3, voffB);
            PG8_BAR; PG8_WAIT_L(0); PG8_MMA(0, 1, At, B1); PG8_BAR;
            PG8_LDA(At, 1, 1); PG8_STAGE(PG8_SA(1, 0), a3, voffA);
            PG8_BAR; PG8_WAIT_L(0); PG8_MMA(1, 0, At, B0); PG8_BAR; PG8_SCHED;
            PG8_STAGE(PG8_SB(1, 1), b3 + hstep, voffB);
            PG8_WAIT_V(6); PG8_BAR; PG8_MMA(1, 1, At, B1); PG8_BAR;
            }
        }
        if constexpr (ALIGN_EPI) { if (wr == 0) PG8_BAR; }
        if constexpr (!Epi::AFTER_DRAIN) { E(acc, cur, wr, wc, fr, fq); S.done(cur); }
        if (!has_next) break;
#pragma unroll
        for (int a = 0; a < 2; ++a)
#pragma unroll
            for (int b = 0; b < 2; ++b)
#pragma unroll
                for (int m = 0; m < 4; ++m)
#pragma unroll
                    for (int n = 0; n < 2; ++n) acc[a][b][m][n] = (f32x4){0.f, 0.f, 0.f, 0.f};
        cur = nxt; cA = nA; cB = nB; ++ui;
        if constexpr (ALIGN_EPI) { if (wr == 1) PG8_BAR; }
    }
    PG8_WAIT_V(0);
    if constexpr (!ALIGN_EPI) { if (wr == 0) PG8_BAR; }
    PG8_BAR;
    if constexpr (Epi::AFTER_DRAIN) { E.fused(acc, cur, wr, wc, fr, fq, lds, wid, lane); S.done(cur); }
#undef PG8_SA
#undef PG8_SB
#undef PG8_STAGE
#undef PG8_LDA
#undef PG8_LDB
#undef PG8_MMA
#undef PG8_WAIT_V
#undef PG8_WAIT_L
#undef PG8_BAR
#undef PG8_SCHED
}
}

constexpr int BATCH = 2, SEQ = 8192, DM = 1024, DEPTH = 2;
constexpr int M = BATCH * SEQ;
constexpr int NPROJ = 3584, FF = 2816, NGU = 2 * FF;
constexpr int RH = 8, CH = 128, NCH = SEQ / CH;
constexpr int C_RQ = 0, C_RK = 512, C_RV = 1024, C_RG = 1536, C_DQ = 2048, C_DK = 2560, C_DV = 3072;
constexpr float EPS = 1e-6f, LOG2E = 1.4426950408889634f;
constexpr size_t MiB = 1u << 20;
constexpr size_t WS_CTL = 0, CTL_BYTES = 1 * MiB;
constexpr size_t WS_WIN = 1 * MiB, WS_WOUT = 15 * MiB, WS_WGU = 19 * MiB, WS_WDN = 41 * MiB;
constexpr size_t WS_XB = 52 * MiB;
constexpr size_t WS_MIX = 84 * MiB, WS_PROJ = 116 * MiB, WS_HID = 116 * MiB, WS_RF = 228 * MiB, WS_RB = 236 * MiB, WS_END = 244 * MiB;
constexpr size_t PAR_OFF = 512 * 1024, BAR_OFF = 768 * 1024;
constexpr int LDS_MISC = 131072;
constexpr int LDS_BYTES = 135168;
constexpr int NWAVES = 8;

#define LAS __attribute__((address_space(3)))
typedef unsigned short bf16;
typedef short bf16x8 __attribute__((ext_vector_type(8)));
typedef short s16x4 __attribute__((ext_vector_type(4)));
typedef short v4i16_t __attribute__((ext_vector_type(4)));
typedef float f32x4 __attribute__((ext_vector_type(4)));
typedef float f32x16 __attribute__((ext_vector_type(16)));
typedef unsigned u32x4 __attribute__((ext_vector_type(4)));
typedef float f32x2_t __attribute__((ext_vector_type(2)));
typedef __bf16 bf16x2_t __attribute__((ext_vector_type(2)));

__device__ __forceinline__ unsigned pk2(float lo, float hi) { f32x2_t v = {lo, hi}; bf16x2_t b = __builtin_convertvector(v, bf16x2_t); return __builtin_bit_cast(unsigned, b); }
__device__ __forceinline__ float bf2f(unsigned short b) { return __uint_as_float((unsigned)b << 16); }
__device__ __forceinline__ float bflo(unsigned w) { return __uint_as_float(w << 16); }
__device__ __forceinline__ float bfhi(unsigned w) { return __uint_as_float(w & 0xffff0000u); }
__device__ __forceinline__ int crow(int r, int hi) { return (r & 3) + 8 * (r >> 2) + 4 * hi; }
__device__ __forceinline__ s16x4 vtr(const LAS unsigned char* p) { return __builtin_bit_cast(s16x4, __builtin_amdgcn_ds_read_tr16_b64_v4i16((LAS v4i16_t*)p)); }
__device__ __forceinline__ bf16x8 cat8(s16x4 lo, s16x4 hi) { return (bf16x8){lo[0], lo[1], lo[2], lo[3], hi[0], hi[1], hi[2], hi[3]}; }
__device__ __forceinline__ void glds16(const void* g, LAS unsigned char* l) { __builtin_amdgcn_global_load_lds((const unsigned*)g, (LAS unsigned*)l, 16, 0, 0); }
__device__ __forceinline__ void glds16a(const void* g, unsigned lds_dst) { unsigned keep; asm volatile("s_mov_b32 %0, m0\n\ts_mov_b32 m0, %2\n\ts_nop 0\n\tglobal_load_lds_dwordx4 %1, off\n\ts_mov_b32 m0, %0" : "=&s"(keep) : "v"(g), "s"(lds_dst) : "memory"); }
#define MFMA32(a, b, c) __builtin_amdgcn_mfma_f32_32x32x16_bf16((a), (b), (c), 0, 0, 0)
#define VMWAIT0() asm volatile("s_waitcnt vmcnt(0)" ::: "memory")
__device__ __forceinline__ float wave_sum(float v) {
#pragma unroll
    for (int o = 1; o < 64; o <<= 1) v += __shfl_xor(v, o);
    return v;
}
__device__ __forceinline__ float half_sum32(float v) {
#pragma unroll
    for (int o = 1; o < 32; o <<= 1) v += __shfl_xor(v, o);
    return v;
}

struct Params { float lam[DEPTH]; float b2[DEPTH]; };

__device__ __forceinline__ void transpose_item(const float* W, int K, int N, bf16* WT, const float* gk, int rowmap, LAS float* scr, int item, int lane) {
    const int nblk = N / 32, kb = item / nblk, nb = item % nblk, k0 = 64 * kb, n0 = 32 * nb;
#pragma unroll 8
    for (int i = 0; i < 32; ++i) { const int kk = 2 * i + (lane >> 5); scr[kk * 33 + (lane & 31)] = W[(size_t)(k0 + kk) * N + n0 + (lane & 31)]; }
    asm volatile("s_waitcnt lgkmcnt(0)" ::: "memory");
    const int c = lane & 7;
    float g8[8];
#pragma unroll
    for (int i = 0; i < 8; ++i) g8[i] = gk ? gk[k0 + 8 * c + i] : 1.0f;
    const int r0 = rowmap == 0 ? n0 : ((n0 >> 7) * 256 + (n0 & 127) + (rowmap == 2 ? 128 : 0));
#pragma unroll
    for (int j = 0; j < 4; ++j) { const int n = (lane >> 3) + 8 * j; const LAS float* s = scr + (8 * c) * 33 + n;
        u32x4 o; o.x = pk2(s[0 * 33] * g8[0], s[1 * 33] * g8[1]); o.y = pk2(s[2 * 33] * g8[2], s[3 * 33] * g8[3]); o.z = pk2(s[4 * 33] * g8[4], s[5 * 33] * g8[5]); o.w = pk2(s[6 * 33] * g8[6], s[7 * 33] * g8[7]);
        *(u32x4*)(WT + (size_t)(r0 + n) * K + k0 + 8 * c) = o; }
    asm volatile("s_waitcnt lgkmcnt(0)" ::: "memory");
}
__device__ __forceinline__ void row_to_bf16_ssq(const float* xrow, bf16* orow, float* ssq, int lane) {
    const f32x4* xr = (const f32x4*)xrow + lane;
    f32x4 v[4]; float s = 0.f;
#pragma unroll
    for (int j = 0; j < 4; ++j) { v[j] = xr[64 * j]; s += (v[j].x * v[j].x + v[j].y * v[j].y) + (v[j].z * v[j].z + v[j].w * v[j].w); }
    s = wave_sum(s);
    unsigned long long* o8 = (unsigned long long*)orow + lane;
#pragma unroll
    for (int j = 0; j < 4; ++j) o8[64 * j] = (unsigned long long)pk2(v[j].x, v[j].y) | ((unsigned long long)pk2(v[j].z, v[j].w) << 32);
    if (lane == 0) *ssq = s;
}

struct Args { const float* in[18]; float* out; unsigned char* ws; int ph_lo, ph_hi; };
struct Frame {
    LAS unsigned char* lds;
    float* out; unsigned char* ws;
    int tid, lane, wave, vcu, G;
};

__device__ __forceinline__ void p0_prologue(Frame& F, const Args& A) {
    LAS float* scr = (LAS float*)(F.lds + F.wave * 16384);
    const int gw = F.vcu * NWAVES + F.wave, NGW = F.G * NWAVES;
    constexpr int I_IN = (DM / 64) * (NPROJ / 32), I_OUT = (DM / 64) * (DM / 32), I_G = (DM / 64) * (FF / 32), I_D = (FF / 64) * (DM / 32);
    constexpr int PER_LAYER = I_IN + I_OUT + 2 * I_G + I_D;
    for (int it = gw; it < DEPTH * PER_LAYER; it += NGW) {
        const int l = it / PER_LAYER; int r = it % PER_LAYER;
        const float* g_attn = A.in[1] + l * DM; const float* g_ffn = A.in[14] + l * DM;
        if (r < I_IN) { transpose_item(A.in[2] + (size_t)l * DM * NPROJ, DM, NPROJ, (bf16*)(F.ws + WS_WIN) + (size_t)l * NPROJ * DM, g_attn, 0, scr, r, F.lane); continue; } r -= I_IN;
        if (r < I_OUT) { transpose_item(A.in[13] + (size_t)l * DM * DM, DM, DM, (bf16*)(F.ws + WS_WOUT) + (size_t)l * DM * DM, nullptr, 0, scr, r, F.lane); continue; } r -= I_OUT;
        if (r < I_G) { transpose_item(A.in[15] + (size_t)l * DM * FF, DM, FF, (bf16*)(F.ws + WS_WGU) + (size_t)l * NGU * DM, g_ffn, 1, scr, r, F.lane); continue; } r -= I_G;
        if (r < I_G) { transpose_item(A.in[16] + (size_t)l * DM * FF, DM, FF, (bf16*)(F.ws + WS_WGU) + (size_t)l * NGU * DM, g_ffn, 2, scr, r, F.lane); continue; } r -= I_G;
        transpose_item(A.in[17] + (size_t)l * FF * DM, FF, DM, (bf16*)(F.ws + WS_WDN) + (size_t)l * DM * FF, nullptr, 0, scr, r, F.lane);
    }
    float* ssq0 = (float*)(F.ws + WS_CTL);
    for (int m = gw; m < M; m += NGW) row_to_bf16_ssq(A.in[0] + (size_t)m * DM, (bf16*)(F.ws + WS_XB) + (size_t)m * DM, ssq0 + m, F.lane);
    if (blockIdx.x == 0 && F.wave == 0) {
        Params* P = (Params*)(F.ws + WS_CTL + PAR_OFF);
        for (int l = 0; l < DEPTH; ++l) {
            const float a = wave_sum(A.in[8][l * 64 + F.lane] * A.in[9][l * 64 + F.lane]), b = wave_sum(A.in[10][l * 64 + F.lane] * A.in[11][l * 64 + F.lane]);
            const float lam_init = 0.8f - 0.6f * expf(-0.3f * (float)l);
            if (F.lane == 0) P->lam[l] = expf(a) - expf(b) + lam_init;
            float gq = fabsf(A.in[6][l * 64 + F.lane]), gk = fabsf(A.in[7][l * 64 + F.lane]);
#pragma unroll
            for (int o = 1; o < 64; o <<= 1) { gq = fmaxf(gq, __shfl_xor(gq, o)); gk = fmaxf(gk, __shfl_xor(gk, o)); }
            if (F.lane == 0) P->b2[l] = 8.0f * LOG2E * 1.02f * gq * gk;
        }
    }
}

__device__ __forceinline__ void qknorm_pass(Frame& F, const Args& A, int l) {
    bf16* PROJ = (bf16*)(F.ws + WS_PROJ);
    const int c = F.tid & 127, sub = F.tid >> 7;
    const bool isq = c < 64; const int d0 = (8 * c) & 63;
    const float* g = (isq ? A.in[6] : A.in[7]) + l * 64 + d0; const float sc = isq ? 0.125f * LOG2E : 1.0f;
    float g8[8];
#pragma unroll
    for (int i = 0; i < 8; ++i) g8[i] = g[i] * sc;
    for (int it = F.vcu; it < M / 4; it += F.G) {
        const int row = 4 * it + sub; u32x4* p = (u32x4*)(PROJ + (size_t)row * NPROJ + C_DQ + 8 * c);
        const u32x4 w = *p; float x[8] = {bflo(w.x), bfhi(w.x), bflo(w.y), bfhi(w.y), bflo(w.z), bfhi(w.z), bflo(w.w), bfhi(w.w)};
        float ss = 0.f;
#pragma unroll
        for (int i = 0; i < 8; ++i) ss += x[i] * x[i];
        ss += __shfl_xor(ss, 1); ss += __shfl_xor(ss, 2); ss += __shfl_xor(ss, 4);
        const float r = __builtin_amdgcn_rsqf(ss * (1.0f / 64.0f) + EPS);
        u32x4 o; o.x = pk2(x[0] * r * g8[0], x[1] * r * g8[1]); o.y = pk2(x[2] * r * g8[2], x[3] * r * g8[3]); o.z = pk2(x[4] * r * g8[4], x[5] * r * g8[5]); o.w = pk2(x[6] * r * g8[6], x[7] * r * g8[7]);
        *p = o;
    }
}
__device__ __forceinline__ int tr_off128(int lane, int r0, int cb) { return (r0 + ((lane & 15) >> 2)) * 128 + (32 * cb + 16 * ((lane >> 4) & 1)) * 2 + 8 * (lane & 3); }

__device__ __forceinline__ void ret_kv_item(Frame& F, const Args& A, int l, int item) {
    const bf16* PROJ = (const bf16*)(F.ws + WS_PROJ);
    const int n = item & 63, h = (item >> 6) & 7, b = item >> 9;
    int lane_ = F.lane; asm volatile("" : "+v"(lane_));
    const int tid_ = (F.wave << 6) | lane_;
    const float lgf2 = -expf(A.in[3][l * RH + h]) * LOG2E, lgb2 = -expf(A.in[4][l * RH + h]) * LOG2E;
    const size_t row0 = (size_t)b * SEQ + (size_t)n * CH;
    LAS unsigned char* LK = F.lds; LAS unsigned char* LVF = F.lds + 16384; LAS unsigned char* LVB = F.lds + 32768;
#pragma unroll
    for (int i = 0; i < 2; ++i) { const int pc = tid_ + 512 * i, s = pc >> 3, ch = pc & 7;
        const u32x4 kw = *(const u32x4*)(PROJ + (row0 + s) * NPROJ + C_RK + h * 64 + 8 * ch);
        const u32x4 vw = *(const u32x4*)(PROJ + (row0 + s) * NPROJ + C_RV + h * 64 + 8 * ch);
        *(LAS u32x4*)(LK + s * 128 + ch * 16) = kw;
        const float wf = __builtin_amdgcn_exp2f(lgf2 * (float)(CH - 1 - s)) * 0.125f, wb = __builtin_amdgcn_exp2f(lgb2 * (float)s) * 0.125f;
        const float x[8] = {bflo(vw.x), bfhi(vw.x), bflo(vw.y), bfhi(vw.y), bflo(vw.z), bfhi(vw.z), bflo(vw.w), bfhi(vw.w)};
        u32x4 a, c2;
        a.x = pk2(x[0] * wf, x[1] * wf); a.y = pk2(x[2] * wf, x[3] * wf); a.z = pk2(x[4] * wf, x[5] * wf); a.w = pk2(x[6] * wf, x[7] * wf);
        c2.x = pk2(x[0] * wb, x[1] * wb); c2.y = pk2(x[2] * wb, x[3] * wb); c2.z = pk2(x[4] * wb, x[5] * wb); c2.w = pk2(x[6] * wb, x[7] * wb);
        *(LAS u32x4*)(LVF + s * 128 + ch * 16) = a; *(LAS u32x4*)(LVB + s * 128 + ch * 16) = c2; }
    __syncthreads();
    const int dir = F.wave >> 2, db = (F.wave >> 1) & 1, eb = F.wave & 1, hi = lane_ >> 5;
    const LAS unsigned char* LV = dir ? LVB : LVF;
    const int tb8 = (8 * hi + ((lane_ & 15) >> 2)) * 128 + 32 * ((lane_ >> 4) & 1) + 8 * (lane_ & 3);
    const LAS unsigned char* pa = LK + tb8 + 64 * db; const LAS unsigned char* pb_ = LV + tb8 + 64 * eb;
    f32x16 acc = {};
#pragma unroll
    for (int st = 0; st < 8; ++st) {
        const bf16x8 a = cat8(vtr(pa + st * 2048), vtr(pa + st * 2048 + 512));
        const bf16x8 bb = cat8(vtr(pb_ + st * 2048), vtr(pb_ + st * 2048 + 512));
        acc = MFMA32(a, bb, acc);
    }
    float* KV = (float*)((unsigned char*)F.out + (dir ? 16 * MiB : 0)) + (size_t)item * 4096;
#pragma unroll
    for (int r = 0; r < 16; ++r) KV[(32 * db + crow(r, hi)) * 64 + 32 * eb + (lane_ & 31)] = acc[r];
    __syncthreads();
}

__device__ __forceinline__ void ret_scan(Frame& F, const Args& A, int l) {
    const int total = 2 * BATCH * RH * 4096;
    for (int gid = F.vcu * 512 + F.tid; gid < total; gid += F.G * 512) {
        const int dir = gid / (BATCH * RH * 4096), rem = gid % (BATCH * RH * 4096), bh = rem >> 12, el = rem & 4095, h = bh & 7;
        const float lg = -expf((dir ? A.in[4] : A.in[3])[l * RH + h]); const float dc = expf(lg * (float)CH);
        const float* KV = (const float*)((unsigned char*)F.out + (dir ? 16 * MiB : 0)) + (size_t)bh * NCH * 4096 + el;
        bf16* R = (bf16*)(F.ws + (dir ? WS_RB : WS_RF)) + (size_t)bh * NCH * 4096 + el;
        float st = 0.f;
        if (dir == 0) {
#pragma unroll 8
            for (int n = 0; n < NCH; ++n) { const float kv = KV[(size_t)n * 4096]; R[(size_t)n * 4096] = (bf16)(pk2(st, 0.f) & 0xffffu); st = dc * st + kv; }
        } else {
#pragma unroll 8
            for (int n = NCH - 1; n >= 0; --n) { const float kv = KV[(size_t)n * 4096]; R[(size_t)n * 4096] = (bf16)(pk2(st, 0.f) & 0xffffu); st = dc * st + kv; }
        }
    }
}

__device__ __forceinline__ void attn_half(Frame& F, const Args& A, int l, int b, int h, int qb, int m) {
    const bf16* PROJ = (const bf16*)(F.ws + WS_PROJ); bf16* OB = (bf16*)((unsigned char*)F.out + 32 * MiB) + (size_t)m * M * 512;
    int lane = F.lane; asm volatile("" : "+v"(lane));
    const int r32 = lane & 31, hi = lane >> 5, wid = F.wave;
    const size_t rowbase = (size_t)b * SEQ; const int q0 = qb * 256 + wid * 32;
    const float B2 = ((const Params*)(F.ws + WS_CTL + PAR_OFF))->b2[l];
    const float slope2 = exp2f(-2.0f * (float)(h + 1)) * LOG2E, nslope2 = -slope2;
    const int dthr = (int)(150.0f / slope2) + 1;
    const int t_lo = max(0, ((qb * 256 - 63 - dthr) >> 6) + 1), t_hi = min(SEQ / 64, (qb * 256 + 255 + dthr + 63) >> 6);
    LAS unsigned char* lds = F.lds;
    LAS float* wsf = (LAS float*)(lds + 73728) + wid * 64;
    const bf16* kvb = PROJ + rowbase * NPROJ;
    const bf16* vsrc = kvb + (size_t)(16 * (wid & 3) + (lane >> 2)) * NPROJ + C_DV + h * 128 + 32 * (wid >> 2) + 8 * (lane & 3);
    const int vlane = ((lane >> 4) & 1) * 32 + (lane & 3) * 8 + (4 * hi + ((lane & 15) >> 2)) * 64;
    const int klane = (r32 >> 3) * 1024 + (r32 & 7) * 128 + ((hi ^ (r32 & 7)) << 4);
    bf16x8 qf[4];
    { const bf16* qrow = PROJ + (rowbase + q0 + r32) * NPROJ + C_DQ + h * 128 + m * 64 + hi * 8;
#pragma unroll
      for (int d0 = 0; d0 < 4; ++d0) qf[d0] = *(const bf16x8*)(qrow + d0 * 16); }
    const bf16* ksrc = kvb + (size_t)(8 * wid + (lane >> 3)) * NPROJ + C_DK + h * 128 + m * 64 + 8 * ((lane & 7) ^ (lane >> 3));
    f32x16 oa[4];
#pragma unroll
    for (int i = 0; i < 4; ++i) oa[i] = f32x16{};
    float ls = 0.f;
    const int n = t_hi - t_lo;
    const int tq = q0 >> 6;
    const unsigned ldsb = (unsigned)(uintptr_t)lds;
    const float dq0 = (float)(q0 + r32 - t_lo * 64 - 4 * hi);
#define DMA_K(i, slot) glds16a(ksrc + (size_t)min(t_lo + (i), SEQ / 64 - 1) * 64 * NPROJ, (unsigned)__builtin_amdgcn_readfirstlane((int)(ldsb + (slot) * 8192 + wid * 1024)))
#define DMA_V(i, slot) do { const bf16* v_ = vsrc + (size_t)min(t_lo + (i), SEQ / 64 - 1) * 64 * NPROJ; const unsigned d_ = (unsigned)__builtin_amdgcn_readfirstlane((int)(ldsb + 24576 + (slot) * 16384 + wid * 1024)); glds16a(v_, d_); glds16a(v_ + 64, d_ + 8192); } while (0)
#define KADDR(p, d0) ((const LAS unsigned char*)(uintptr_t)((unsigned)(uintptr_t)(p) ^ (unsigned)((d0) << 5)))
#define BIAS(S0, S1, i) do { const float dq_ = dq0 - 64.0f * (float)(i); _Pragma("unroll") for (int r = 0; r < 16; ++r) { const float c = (float)((r & 3) + 8 * (r >> 2)); \
        S0[r] = nslope2 * fabsf(dq_ - c) - B2; S1[r] = nslope2 * fabsf(dq_ - (c + 32.0f)) - B2; } } while (0)
#define QK_ACC(S0, S1, slot) do { const LAS unsigned char* kp_ = lds + (slot) * 8192 + klane; _Pragma("unroll") for (int d0 = 0; d0 < 4; ++d0) { \
        const LAS unsigned char* ka_ = KADDR(kp_, d0); const bf16x8 b0 = *(const LAS bf16x8*)(ka_); const bf16x8 b1 = *(const LAS bf16x8*)(ka_ + 4096); \
        S0 = MFMA32(b0, qf[d0], S0); S1 = MFMA32(b1, qf[d0], S1); } } while (0)
#define FENCE() __builtin_amdgcn_sched_barrier(0)
#define EXP4(C, k, s_) do { C[k] = __builtin_amdgcn_exp2f(C[k]); C[(k) + 1] = __builtin_amdgcn_exp2f(C[(k) + 1]); C[(k) + 2] = __builtin_amdgcn_exp2f(C[(k) + 2]); C[(k) + 3] = __builtin_amdgcn_exp2f(C[(k) + 3]); \
        s_ += (C[k] + C[(k) + 1]) + (C[(k) + 2] + C[(k) + 3]); } while (0)
#define PACK8(C, k) (u32x4){pk2(C[k], C[(k) + 1]), pk2(C[(k) + 2], C[(k) + 3]), pk2(C[(k) + 4], C[(k) + 5]), pk2(C[(k) + 6], C[(k) + 7])}
#define KLD(dst0, dst1, d0) do { const LAS unsigned char* ka_ = KADDR(kp_, d0); dst0 = *(const LAS bf16x8*)(ka_); dst1 = *(const LAS bf16x8*)(ka_ + 4096); } while (0)
#define VLD(dst, off) dst = cat8(vtr(vb_ + (off)), vtr(vb_ + (off) + 512))
#define BIAS4(S0, S1, k, dq_) do { if (strad_) { _Pragma("unroll") for (int r = (k); r < (k) + 4; ++r) { const float c = (float)((r & 3) + 8 * (r >> 2)); \
        S0[r] = nslope2 * fabsf(dq_ - c) - B2; S1[r] = nslope2 * fabsf(dq_ - (c + 32.0f)) - B2; } } \
      else { BIAS4F_##k(S0, S1); } } while (0)
#define FMK(dst, base, K) do { float t_; asm("v_fmamk_f32 %0, %1, " #K ", %2" : "=v"(t_) : "v"(sg_), "v"(base)); dst = t_; } while (0)
#define BIAS4F_0(S0, S1) do { FMK(S0[0], base0_, 0x00000000); FMK(S1[0], base1_, 0x00000000); FMK(S0[1], base0_, 0x3f800000); FMK(S1[1], base1_, 0x3f800000); FMK(S0[2], base0_, 0x40000000); FMK(S1[2], base1_, 0x40000000); FMK(S0[3], base0_, 0x40400000); FMK(S1[3], base1_, 0x40400000); } while (0)
#define BIAS4F_4(S0, S1) do { FMK(S0[4], base0_, 0x41000000); FMK(S1[4], base1_, 0x41000000); FMK(S0[5], base0_, 0x41100000); FMK(S1[5], base1_, 0x41100000); FMK(S0[6], base0_, 0x41200000); FMK(S1[6], base1_, 0x41200000); FMK(S0[7], base0_, 0x41300000); FMK(S1[7], base1_, 0x41300000); } while (0)
#define BIAS4F_8(S0, S1) do { FMK(S0[8], base0_, 0x41800000); FMK(S1[8], base1_, 0x41800000); FMK(S0[9], base0_, 0x41880000); FMK(S1[9], base1_, 0x41880000); FMK(S0[10], base0_, 0x41900000); FMK(S1[10], base1_, 0x41900000); FMK(S0[11], base0_, 0x41980000); FMK(S1[11], base1_, 0x41980000); } while (0)
#define BIAS4F_12(S0, S1) do { FMK(S0[12], base0_, 0x41c00000); FMK(S1[12], base1_, 0x41c00000); FMK(S0[13], base0_, 0x41c80000); FMK(S1[13], base1_, 0x41c80000); FMK(S0[14], base0_, 0x41d00000); FMK(S1[14], base1_, 0x41d00000); FMK(S0[15], base0_, 0x41d80000); FMK(S1[15], base1_, 0x41d80000); } while (0)
#define STEP(C0, C1, N0, N1, i) do { \
        DMA_K((i) + 3, r0); DMA_V((i) + 2, r2);     \
        const LAS unsigned char* kp_ = lds + r1 * 8192 + klane; \
        const LAS unsigned char* vb_ = lds + 24576 + r0 * 16384 + vlane; \
        const float dq2_ = dq0 - 64.0f * (float)((i) + 2); \
        const int tt_ = t_lo + (i) + 2; const bool strad_ = (tt_ == tq); const float sg_ = (tt_ < tq) ? slope2 : nslope2; const float base0_ = -sg_ * dq2_ - B2, base1_ = base0_ + 32.0f * sg_; \
        float s_ = 0.f; bf16x8 ka0, ka1, va, vb2, vc, vd; u32x4 pw0, pw1, pw2, pw3; \
        KLD(ka0, ka1, 0); \
        FENCE(); \
          \
        N0 = MFMA32(ka0, qf[0], N0); N1 = MFMA32(ka1, qf[0], N1); KLD(ka0, ka1, 1); EXP4(C0, 0, s_); FENCE(); \
        N0 = MFMA32(ka0, qf[1], N0); N1 = MFMA32(ka1, qf[1], N1); KLD(ka0, ka1, 2); EXP4(C0, 4, s_); pw0 = PACK8(C0, 0); FENCE(); \
        N0 = MFMA32(ka0, qf[2], N0); N1 = MFMA32(ka1, qf[2], N1); KLD(ka0, ka1, 3); EXP4(C0, 8, s_); FENCE(); \
        N0 = MFMA32(ka0, qf[3], N0); N1 = MFMA32(ka1, qf[3], N1); VLD(va, 0); VLD(vb2, 4096); EXP4(C0, 12, s_); pw1 = PACK8(C0, 8); FENCE(); \
          \
        VLD(vc, 8192); VLD(vd, 12288); oa[0] = MFMA32(__builtin_bit_cast(bf16x8, pw0), va, oa[0]); oa[1] = MFMA32(__builtin_bit_cast(bf16x8, pw0), vb2, oa[1]); EXP4(C1, 0, s_); FENCE(); \
        VLD(va, 1024); VLD(vb2, 5120); oa[2] = MFMA32(__builtin_bit_cast(bf16x8, pw0), vc, oa[2]); oa[3] = MFMA32(__builtin_bit_cast(bf16x8, pw0), vd, oa[3]); EXP4(C1, 4, s_); pw2 = PACK8(C1, 0); FENCE(); \
        VLD(vc, 9216); VLD(vd, 13312); oa[0] = MFMA32(__builtin_bit_cast(bf16x8, pw1), va, oa[0]); oa[1] = MFMA32(__builtin_bit_cast(bf16x8, pw1), vb2, oa[1]); EXP4(C1, 8, s_); FENCE(); \
        VLD(va, 2048); VLD(vb2, 6144); oa[2] = MFMA32(__builtin_bit_cast(bf16x8, pw1), vc, oa[2]); oa[3] = MFMA32(__builtin_bit_cast(bf16x8, pw1), vd, oa[3]); EXP4(C1, 12, s_); pw3 = PACK8(C1, 8); FENCE(); \
        ls += s_; \
        VLD(vc, 10240); VLD(vd, 14336); oa[0] = MFMA32(__builtin_bit_cast(bf16x8, pw2), va, oa[0]); oa[1] = MFMA32(__builtin_bit_cast(bf16x8, pw2), vb2, oa[1]); BIAS4(C0, C1, 0, dq2_); FENCE(); \
        VLD(va, 3072); VLD(vb2, 7168); oa[2] = MFMA32(__builtin_bit_cast(bf16x8, pw2), vc, oa[2]); oa[3] = MFMA32(__builtin_bit_cast(bf16x8, pw2), vd, oa[3]); BIAS4(C0, C1, 4, dq2_); FENCE(); \
        VLD(vc, 11264); VLD(vd, 15360); oa[0] = MFMA32(__builtin_bit_cast(bf16x8, pw3), va, oa[0]); oa[1] = MFMA32(__builtin_bit_cast(bf16x8, pw3), vb2, oa[1]); BIAS4(C0, C1, 8, dq2_); FENCE(); \
        oa[2] = MFMA32(__builtin_bit_cast(bf16x8, pw3), vc, oa[2]); oa[3] = MFMA32(__builtin_bit_cast(bf16x8, pw3), vd, oa[3]); BIAS4(C0, C1, 12, dq2_); FENCE(); \
        asm volatile("s_waitcnt vmcnt(3)" ::: "memory"); \
        __syncthreads(); { const int t_ = r0; r0 = r1; r1 = r2; r2 = t_; } } while (0)
    f32x16 A0, A1, B0, B1;
    if (wid >= 4) __builtin_amdgcn_s_setprio(1);
    int r0 = 0, r1 = 1, r2 = 2;
    DMA_K(0, 0); DMA_V(0, 0); DMA_K(1, 1); DMA_V(1, 1); DMA_K(2, 2);
    BIAS(A0, A1, 0);
    VMWAIT0(); __syncthreads();
    { const LAS unsigned char* kp_ = lds + klane; _Pragma("unroll") for (int d0 = 0; d0 < 4; ++d0) {
        const LAS unsigned char* ka_ = KADDR(kp_, d0); const bf16x8 b0 = *(const LAS bf16x8*)(ka_); const bf16x8 b1 = *(const LAS bf16x8*)(ka_ + 4096);
        A0 = MFMA32(b0, qf[d0], A0); A1 = MFMA32(b1, qf[d0], A1); } }
    BIAS(B0, B1, 1);
    asm volatile("s_waitcnt lgkmcnt(0)" ::: "memory"); __syncthreads();
#pragma unroll 1
    for (int i = 0;; i += 2) {
        STEP(A0, A1, B0, B1, i);
        if (i + 1 >= n) break;
        STEP(B0, B1, A0, A1, i + 1);
        if (i + 2 >= n) break;
    }
    VMWAIT0();
    __builtin_amdgcn_s_setprio(0);
#undef DMA_K
#undef DMA_V
#undef BIAS
#undef QK_ACC
#undef KADDR
#undef STEP
#undef FENCE
#undef EXP4
#undef PACK8
#undef KLD
#undef VLD
#undef BIAS4
    ls += __shfl_xor(ls, 32);
    int le = lane; asm volatile("" : "+v"(le));
    const int r32e = le & 31, hie = le >> 5;
    if (hie == 0) wsf[r32e] = 1.0f / ls;
    asm volatile("s_waitcnt lgkmcnt(0)" ::: "memory");
#pragma unroll
    for (int r = 0; r < 16; ++r) {
        const int qr = crow(r, hie); const float a1 = wsf[qr];
        bf16* orow = OB + (rowbase + q0 + qr) * 512 + h * 128 + r32e;
#pragma unroll
        for (int db = 0; db < 4; ++db) orow[32 * db] = (bf16)(pk2(oa[db][r] * a1, 0.f) & 0xffffu);
        asm volatile("" ::: "memory");
    }
    __syncthreads();
}
__device__ __forceinline__ void attn_combine(Frame& F, const Args& A, int l) {
    const bf16* OB0 = (const bf16*)((unsigned char*)F.out + 32 * MiB); const bf16* OB1 = OB0 + (size_t)M * 512; bf16* MIX = (bf16*)(F.ws + WS_MIX);
    const Params* P = (const Params*)(F.ws + WS_CTL + PAR_OFF);
    const float lam = P->lam[l], post = 1.0f - (0.8f - 0.6f * expf(-0.3f * (float)l));
    const int c16 = F.tid & 15, grp = F.tid >> 4;
    float g8[8];
#pragma unroll
    for (int i = 0; i < 8; ++i) g8[i] = A.in[12][l * 128 + 8 * c16 + i] * post;
    for (int it = F.vcu; it < M * 4 / 32; it += F.G) {
        const int gi = it * 32 + grp, row = gi >> 2, h = gi & 3;
        const size_t off = (size_t)row * 512 + h * 128 + 8 * c16;
        const u32x4 a = *(const u32x4*)(OB0 + off), bq = *(const u32x4*)(OB1 + off);
        float v[8] = {bflo(a.x) - lam * bflo(bq.x), bfhi(a.x) - lam * bfhi(bq.x), bflo(a.y) - lam * bflo(bq.y), bfhi(a.y) - lam * bfhi(bq.y),
                      bflo(a.z) - lam * bflo(bq.z), bfhi(a.z) - lam * bfhi(bq.z), bflo(a.w) - lam * bflo(bq.w), bfhi(a.w) - lam * bfhi(bq.w)};
        float ss = 0.f;
#pragma unroll
        for (int i = 0; i < 8; ++i) ss += v[i] * v[i];
        ss += __shfl_xor(ss, 1); ss += __shfl_xor(ss, 2); ss += __shfl_xor(ss, 4); ss += __shfl_xor(ss, 8);
        const float rs = __builtin_amdgcn_rsqf(ss * (1.0f / 128.0f) + EPS);
        u32x4 o; o.x = pk2(v[0] * rs * g8[0], v[1] * rs * g8[1]); o.y = pk2(v[2] * rs * g8[2], v[3] * rs * g8[3]); o.z = pk2(v[4] * rs * g8[4], v[5] * rs * g8[5]); o.w = pk2(v[6] * rs * g8[6], v[7] * rs * g8[7]);
        *(u32x4*)(MIX + (size_t)row * DM + 512 + h * 128 + 8 * c16) = o;
    }
}

__device__ __forceinline__ void ret_out_pair(Frame& F, const Args& A, int l, int pair) {
    const bf16* PROJ = (const bf16*)(F.ws + WS_PROJ); bf16* MIX = (bf16*)(F.ws + WS_MIX);
    int lane = F.lane; asm volatile("" : "+v"(lane));
    const int r32 = lane & 31, hi = lane >> 5, grp = F.wave >> 2, wq = F.wave & 3, gt = (wq << 6) | lane;
    const int item = 2 * pair + grp; const int n = item & 63, h = (item >> 6) & 7, b = item >> 9;
    const float lgf2 = -expf(A.in[3][l * RH + h]) * LOG2E, lgb2 = -expf(A.in[4][l * RH + h]) * LOG2E;
    const size_t row0 = (size_t)b * SEQ + (size_t)n * CH;
    LAS unsigned char* LV = F.lds + grp * 32768; LAS unsigned char* LRF = LV + 16384; LAS unsigned char* LRB = LV + 24576;
    const bf16* RF = (const bf16*)(F.ws + WS_RF) + (size_t)item * 4096; const bf16* RB = (const bf16*)(F.ws + WS_RB) + (size_t)item * 4096;
#pragma unroll
    for (int i = 0; i < 4; ++i) { const int pc = gt + 256 * i, s = pc >> 3, ch = pc & 7;
        *(LAS u32x4*)(LV + s * 128 + ch * 16) = *(const u32x4*)(PROJ + (row0 + s) * NPROJ + C_RV + h * 64 + 8 * ch); }
#pragma unroll
    for (int i = 0; i < 2; ++i) { const int pc = gt + 256 * i;
        *(LAS u32x4*)(LRF + pc * 16) = *(const u32x4*)(RF + pc * 8); *(LAS u32x4*)(LRB + pc * 16) = *(const u32x4*)(RB + pc * 8); }
    const int t0 = 32 * wq;
    LAS unsigned char* GW = F.lds + 65536 + F.wave * 8192;
#pragma unroll
    for (int i = 0; i < 4; ++i) { const int pc = lane + 64 * i, rw = pc >> 3, ch = pc & 7;
        *(LAS u32x4*)(GW + rw * 128 + ch * 16) = *(const u32x4*)(PROJ + (row0 + t0 + rw) * NPROJ + C_RG + h * 64 + 8 * ch); }
    bf16x8 qf[4];
    { const bf16* qrow = PROJ + (row0 + t0 + r32) * NPROJ + C_RQ + h * 64 + hi * 8;
#pragma unroll
      for (int d0 = 0; d0 < 4; ++d0) qf[d0] = *(const bf16x8*)(qrow + d0 * 16); }
    f32x16 X[4];
#pragma unroll
    for (int sb = 0; sb < 4; ++sb) { X[sb] = f32x16{};
        const bf16* krow = PROJ + (row0 + 32 * sb + r32) * NPROJ + C_RK + h * 64 + hi * 8;
#pragma unroll
        for (int d0 = 0; d0 < 4; ++d0) { const bf16x8 kf = *(const bf16x8*)(krow + d0 * 16); X[sb] = MFMA32(kf, qf[d0], X[sb]); } }
    u32x4 pw[8];
    const float tf = (float)(t0 + r32);
#pragma unroll
    for (int sb = 0; sb < 4; ++sb) {
#pragma unroll
        for (int r = 0; r < 16; ++r) { const float dl = tf - (float)(32 * sb + crow(r, hi)); const float e = lgf2 * fmaxf(dl, 0.f) + lgb2 * fmaxf(-dl, 0.f); X[sb][r] *= __builtin_amdgcn_exp2f(e - 3.0f); }
        pw[2 * sb] = (u32x4){pk2(X[sb][0], X[sb][1]), pk2(X[sb][2], X[sb][3]), pk2(X[sb][4], X[sb][5]), pk2(X[sb][6], X[sb][7])};
        pw[2 * sb + 1] = (u32x4){pk2(X[sb][8], X[sb][9]), pk2(X[sb][10], X[sb][11]), pk2(X[sb][12], X[sb][13]), pk2(X[sb][14], X[sb][15])};
    }
    __builtin_amdgcn_sched_barrier(0);
    __syncthreads();
    const int q4 = (lane & 15) >> 2, tcol = 32 * ((lane >> 4) & 1) + 8 * (lane & 3);
    const LAS unsigned char* pv = LV + (4 * hi + q4) * 128 + tcol;
    const LAS unsigned char* prf = LRF + (8 * hi + q4) * 128 + tcol;
    const LAS unsigned char* prb = LRB + (8 * hi + q4) * 128 + tcol;
    f32x16 aI[2], aF[2], aB[2];
#pragma unroll
    for (int eb = 0; eb < 2; ++eb) { aI[eb] = f32x16{};
#pragma unroll
        for (int ks = 0; ks < 8; ++ks) {
            const bf16x8 vf = cat8(vtr(pv + ks * 2048 + 64 * eb), vtr(pv + ks * 2048 + 1024 + 64 * eb));
            aI[eb] = MFMA32(__builtin_bit_cast(bf16x8, pw[ks]), vf, aI[eb]); } }
    __builtin_amdgcn_sched_barrier(0);
#pragma unroll
    for (int eb = 0; eb < 2; ++eb) { aF[eb] = f32x16{}; aB[eb] = f32x16{};
#pragma unroll
        for (int d0 = 0; d0 < 4; ++d0) {
            const bf16x8 rf = cat8(vtr(prf + d0 * 2048 + 64 * eb), vtr(prf + d0 * 2048 + 512 + 64 * eb));
            const bf16x8 rb = cat8(vtr(prb + d0 * 2048 + 64 * eb), vtr(prb + d0 * 2048 + 512 + 64 * eb));
            aF[eb] = MFMA32(qf[d0], rf, aF[eb]); aB[eb] = MFMA32(qf[d0], rb, aB[eb]); } }
    __builtin_amdgcn_sched_barrier(0);
    const float* rng = A.in[5] + l * 64; const float g0 = rng[r32], g1 = rng[32 + r32];
#pragma unroll
    for (int r = 0; r < 16; ++r) {
        const int tl = t0 + crow(r, hi);
        const float wf = __builtin_amdgcn_exp2f(lgf2 * (float)(tl + 1)), wb = __builtin_amdgcn_exp2f(lgb2 * (float)(CH - tl));
        const float v0 = aI[0][r] + wf * aF[0][r] + wb * aB[0][r], v1 = aI[1][r] + wf * aF[1][r] + wb * aB[1][r];
        const float ss = half_sum32(v0 * v0 + v1 * v1); const float rs = __builtin_amdgcn_rsqf(ss * (1.0f / 64.0f) + EPS);
        const LAS unsigned short* grow = (const LAS unsigned short*)(GW + crow(r, hi) * 128) + r32;
        const float ga = bf2f(grow[0]), gb = bf2f(grow[32]);
        const float sa = ga * __builtin_amdgcn_rcpf(1.0f + __builtin_amdgcn_exp2f(-LOG2E * ga)), sb2 = gb * __builtin_amdgcn_rcpf(1.0f + __builtin_amdgcn_exp2f(-LOG2E * gb));
        LAS unsigned short* orow = (LAS unsigned short*)(GW + 4096 + crow(r, hi) * 128) + r32;
        orow[0] = (unsigned short)(pk2(v0 * rs * g0 * sa, 0.f) & 0xffffu); orow[32] = (unsigned short)(pk2(v1 * rs * g1 * sb2, 0.f) & 0xffffu);
    }
    asm volatile("s_waitcnt lgkmcnt(0)" ::: "memory");
#pragma unroll
    for (int i = 0; i < 4; ++i) { const int pc = lane + 64 * i, rw = pc >> 3, ch = pc & 7;
        *(u32x4*)(MIX + (row0 + t0 + rw) * DM + h * 64 + 8 * ch) = *(const LAS u32x4*)(GW + 4096 + rw * 128 + ch * 16); }
    __syncthreads();
}

#define XB_TMO      128
#define XB_XCNT(j)  (256  + 64 * (j))
#define XB_XSUB(j)  (1280 + 64 * (j))
#define XB_XGEN(j)  (2304 + 64 * (j))
#define XB_TOP      3328
#define XB_TOPGEN   3392
#define XCD_BAR_WORDS 3456
#define XB_SPIN_CAP (1u << 18)

__device__ __forceinline__ unsigned xb_ld(unsigned* p)              { return __hip_atomic_load(p, __ATOMIC_RELAXED, __HIP_MEMORY_SCOPE_AGENT); }
__device__ __forceinline__ unsigned xb_add(unsigned* p, unsigned v) { return __hip_atomic_fetch_add(p, v, __ATOMIC_RELAXED, __HIP_MEMORY_SCOPE_AGENT); }
__device__ __forceinline__ unsigned xb_xcc_id() { return (unsigned)__builtin_amdgcn_s_getreg((3 << 11) | 20) & 0xFu; }
#define XB_SPIN(cond, bar) do { unsigned _sp = 0; while (cond) { __builtin_amdgcn_s_sleep(1); \
    if ((++_sp & 255u) == 0u) { if (xb_ld(&(bar)[XB_TMO])) break; if (_sp > XB_SPIN_CAP) { atomicAdd(&(bar)[XB_TMO], 1u); break; } } } } while (0)

struct XcdBarrier {
    unsigned* bar; unsigned x;
    volatile LAS unsigned* st;
};

__device__ __forceinline__ XcdBarrier xcd_barrier_post(unsigned* bar, volatile LAS unsigned* st) {
    XcdBarrier b; b.bar = bar; b.x = xb_xcc_id(); b.st = st;
    if (threadIdx.x == 0) (void)xb_add(&bar[XB_XCNT(b.x)], 1u);
    return b;
}
__device__ __forceinline__ void xcd_barrier_complete(unsigned* bar, unsigned x, unsigned& nloc, unsigned& nx) {
    const unsigned G = gridDim.x * gridDim.y * gridDim.z;
    unsigned sum, cnt, mine, sp = 0u;
    for (;;) {
        sum = 0u; cnt = 0u; mine = 0u;
#pragma unroll
        for (unsigned j = 0; j < 16; ++j) { const unsigned c = xb_ld(&bar[XB_XCNT(j)]); sum += c; cnt += (c > 0u) ? 1u : 0u; mine = (j == x) ? c : mine; }
        if (sum == G) break;
        __builtin_amdgcn_s_sleep(1);
        if ((++sp & 255u) == 0u) { if (xb_ld(&bar[XB_TMO])) break; if (sp > XB_SPIN_CAP) { atomicAdd(&bar[XB_TMO], 1u); break; } }
    }
    nloc = mine > 0u ? mine : 1u; nx = cnt > 0u ? cnt : 1u;
}

__device__ __forceinline__ void xcd_barrier(const XcdBarrier& b) {
    asm volatile("s_waitcnt vmcnt(0)" ::: "memory");
    __syncthreads();
    if (threadIdx.x == 0) {
        unsigned* bar = b.bar;
        __builtin_amdgcn_s_waitcnt(0);
        unsigned nloc = b.st[0], nx = b.st[1];
        if (nloc == 0u) { xcd_barrier_complete(bar, b.x, nloc, nx); b.st[0] = nloc; b.st[1] = nx; }
        const unsigned old = xb_add(&bar[XB_XSUB(b.x)], 1u);
        const unsigned gen = old / nloc;
        if (old + 1u == (gen + 1u) * nloc) {
            __builtin_amdgcn_fence(__ATOMIC_RELEASE, "agent");
            asm volatile("s_waitcnt vmcnt(0)" ::: "memory");
            const unsigned og = xb_add(&bar[XB_TOP], 1u);
            const unsigned tg = og / nx;
            if (og + 1u == (tg + 1u) * nx) xb_add(&bar[XB_TOPGEN], 1u);
            else XB_SPIN(xb_ld(&bar[XB_TOPGEN]) == tg, bar);
            __builtin_amdgcn_fence(__ATOMIC_ACQUIRE, "agent");
            xb_add(&bar[XB_XGEN(b.x)], 1u);
            asm volatile("s_waitcnt vmcnt(0)" ::: "memory");
        } else {
            XB_SPIN(xb_ld(&bar[XB_XGEN(b.x)]) == gen, bar);
            __builtin_amdgcn_fence(__ATOMIC_ACQUIRE, "agent");
            asm volatile("s_waitcnt vmcnt(0)" ::: "memory");
        }
    }
    __syncthreads();
}

constexpr int N_PHASES = 1 + 7 * DEPTH;

__global__ void __launch_bounds__(NWAVES * 64, 2) fwd_megakernel(Args args) {
    extern __shared__ __attribute__((aligned(1024))) unsigned char lds_raw[];
    cg::grid_group grid = cg::this_grid();
    Frame F0;
    F0.lds = (LAS unsigned char*)lds_raw;
    F0.tid = threadIdx.x; F0.lane = F0.tid & 63; F0.wave = __builtin_amdgcn_readfirstlane(F0.tid >> 6);
    F0.G = gridDim.x; { const int bx0 = blockIdx.x; F0.vcu = (F0.G % 8 == 0) ? (bx0 % 8) * (F0.G / 8) + bx0 / 8 : bx0; }
    F0.out = args.out; F0.ws = args.ws;
    const int lo = args.ph_lo, hi = args.ph_hi;
    for (int u = threadIdx.x; u < 64; u += NWAVES * 64) ((LAS unsigned*)(F0.lds + LDS_MISC))[u] = 0u;
    __syncthreads();
    (void)xcd_barrier_post((unsigned*)(args.ws + WS_CTL + BAR_OFF), (volatile LAS unsigned*)(F0.lds + LDS_MISC) + 8);
#define IN(k) (lo <= (k) && (k) < hi)
    if (lo < 0) grid.sync();
#define xcd_seam() do { if (IN(pb + 3)) { unsigned char* w_ = args.ws; asm volatile("" : "+s"(w_)); XcdBarrier b_; b_.bar = (unsigned*)(w_ + WS_CTL + BAR_OFF); b_.x = xb_xcc_id(); b_.st = (volatile LAS unsigned*)(F0.lds + LDS_MISC) + 8; xcd_barrier(b_); } } while (0)
#define SEAM(k) do { if (IN(k) && IN((k) + 1)) { unsigned char* w_ = args.ws; asm volatile("" : "+s"(w_)); XcdBarrier b_; b_.bar = (unsigned*)(w_ + WS_CTL + BAR_OFF); b_.x = xb_xcc_id(); b_.st = (volatile LAS unsigned*)(F0.lds + LDS_MISC) + 8; xcd_barrier(b_); } } while (0)
#define PH_BEGIN() Frame F = F0; int bx = (int)blockIdx.x; asm volatile("" : "+s"(F.ws), "+s"(F.out), "+s"(F.G), "+s"(F.vcu), "+s"(bx), "+s"(F.wave), "+v"(F.lane)); F.tid = (F.wave << 6) | F.lane; \
    float* SSQ = (float*)(F.ws + WS_CTL); bf16* XB = (bf16*)(F.ws + WS_XB); bf16* PROJ = (bf16*)(F.ws + WS_PROJ); bf16* MIX = (bf16*)(F.ws + WS_MIX); bf16* HID = (bf16*)(F.ws + WS_HID); \
    (void)SSQ; (void)XB; (void)PROJ; (void)MIX; (void)HID; (void)bx;
#ifndef SKIP_P0
    if (IN(0)) { PH_BEGIN(); p0_prologue(F, args); }
#endif
    SEAM(0);
#pragma unroll
    for (int l = 0; l < DEPTH; ++l) {
        const int pb = 1 + 7 * l;
#ifndef SKIP_G1
        if (IN(pb)) {
            PH_BEGIN();
            pg8::Gemm g{XB, (const bf16*)(F.ws + WS_WIN) + (size_t)l * NPROJ * DM, M, NPROJ, DM}; pg8::StaticOrder S; S.init(M, NPROJ, F.G, bx);
            pg8::EpiProj E{PROJ, NPROJ, SSQ + (size_t)(2 * l) * M};
            pg8::gemm_phase<pg8::EpiProj, pg8::StaticOrder, true, true>(F.lds, g, S, E, F.tid);
        }
#endif
        SEAM(pb);
        if (IN(pb + 1)) {
            PH_BEGIN();
#ifndef SKIP_RKV
            for (int it = F.vcu; it < BATCH * RH * NCH; it += F.G) ret_kv_item(F, args, l, it);
#endif
            qknorm_pass(F, args, l);
        } SEAM(pb + 1);
        if (IN(pb + 2)) { PH_BEGIN(); ret_scan(F, args, l); } SEAM(pb + 2);
        if (IN(pb + 3)) {
            PH_BEGIN();
#pragma unroll 1
            for (int it = F.vcu; it < 512; it += F.G) {
                const int k = it >> 8, v = it & 255, x = v >> 5, j = v & 31, bb = (x >> 1) & 1, mm = x >> 2;
                const int hh = k == 0 ? 3 - (x & 1) : ((x & 1) ? 1 : 0), qq = (k == 1 && (x & 1)) ? ((j + 16) & 31) : j;
                attn_half(F, args, l, bb, hh, qq, mm);
            }
            {
                const bool g256 = (F.G == 256); const bool take = g256 ? !((F.vcu >> 5) & 1) : true;
                const int rs = g256 ? ((F.vcu >> 6) * 32 + (F.vcu & 31)) : F.vcu, rstride = g256 ? 128 : F.G;
                if (take) {
#pragma unroll 1
                    for (int pr = rs; pr < BATCH * RH * NCH / 2; pr += rstride) ret_out_pair(F, args, l, pr);
                }
            }
        } xcd_seam();
        if (IN(pb + 3)) { PH_BEGIN(); attn_combine(F, args, l); }
        SEAM(pb + 3);
#ifndef SKIP_G2
        if (IN(pb + 4)) {
            PH_BEGIN();
            pg8::Gemm g{MIX, (const bf16*)(F.ws + WS_WOUT) + (size_t)l * DM * DM, M, DM, DM}; pg8::StaticOrder S; S.init(M, DM, F.G, bx);
            pg8::EpiRes E{XB, nullptr, SSQ + (size_t)(2 * l + 1) * M};
            pg8::gemm_phase<pg8::EpiRes, pg8::StaticOrder, true, true>(F.lds, g, S, E, F.tid);
        }
#endif
        SEAM(pb + 4);
#ifndef SKIP_G3
        if (IN(pb + 5)) {
            PH_BEGIN();
            pg8::Gemm g{XB, (const bf16*)(F.ws + WS_WGU) + (size_t)l * NGU * DM, M, NGU, DM}; pg8::StaticOrder S; S.init(M, NGU, F.G, bx);
            pg8::EpiSwiglu E{HID, FF, SSQ + (size_t)(2 * l + 1) * M};
            pg8::gemm_phase<pg8::EpiSwiglu, pg8::StaticOrder, true, true>(F.lds, g, S, E, F.tid);
        }
#endif
        SEAM(pb + 5);
#ifndef SKIP_G4
        if (IN(pb + 6)) {
            PH_BEGIN();
            pg8::Gemm g{HID, (const bf16*)(F.ws + WS_WDN) + (size_t)l * DM * FF, M, DM, FF}; pg8::StaticOrder S; S.init(M, DM, F.G, bx);
            const bool last = (l == DEPTH - 1);
            pg8::EpiRes E{XB, last ? F.out : nullptr, SSQ + (size_t)(2 * l + 2 < 4 ? 2 * l + 2 : 0) * M};
            pg8::gemm_phase<pg8::EpiRes, pg8::StaticOrder, true, true>(F.lds, g, S, E, F.tid);
        }
#endif
        SEAM(pb + 6);
    }
#undef IN
#undef SEAM
}

#ifndef MK_N_LAUNCHES
#define MK_N_LAUNCHES 1
#endif
extern "C" void kernel_launch(void* const* d_in, const int* in_sizes, int n_in, void* d_out, int out_size, void* d_ws, size_t ws_size, hipStream_t stream) {
    static int grid = 0;
    if (grid == 0) {
        if (n_in != 18 || out_size != M * DM || ws_size < WS_END) { fprintf(stderr, "kernel_launch: unexpected shapes (n_in %d out %d ws %zu)\n", n_in, out_size, ws_size); grid = -1; return; }
        int dev = 0, cus = 0, per_cu = 0;
        hipGetDevice(&dev); hipDeviceGetAttribute(&cus, hipDeviceAttributeMultiprocessorCount, dev);
        if (hipFuncSetAttribute((const void*)fwd_megakernel, hipFuncAttributeMaxDynamicSharedMemorySize, LDS_BYTES) != hipSuccess) { fprintf(stderr, "kernel_launch: hipFuncSetAttribute failed\n"); grid = -1; return; }
        if (hipOccupancyMaxActiveBlocksPerMultiprocessor(&per_cu, (const void*)fwd_megakernel, NWAVES * 64, LDS_BYTES) != hipSuccess || per_cu < 1) { fprintf(stderr, "kernel_launch: occupancy query failed (%d)\n", per_cu); (void)hipGetLastError(); per_cu = 1; }
        grid = cus * per_cu;
    }
    if (grid < 0) return;
    hipMemsetAsync((char*)d_ws + WS_CTL, 0, CTL_BYTES, stream);
    Args a{};
    for (int i = 0; i < 18; ++i) a.in[i] = (const float*)d_in[i];
    a.out = (float*)d_out; a.ws = (unsigned char*)d_ws;
    const int nl = MK_N_LAUNCHES;
    for (int li = 0; li < nl; ++li) {
        a.ph_lo = (nl == 1) ? 0 : li; a.ph_hi = (nl == 1) ? N_PHASES : li + 1;
        void* kargs[] = {&a};
        hipError_t e = hipLaunchCooperativeKernel((const void*)fwd_megakernel, dim3(grid), dim3(NWAVES * 64), kargs, LDS_BYTES, stream);
        if (e != hipSuccess) { fprintf(stderr, "kernel_launch: cooperative launch %d failed: %s (grid %d)\n", li, hipGetErrorString(e), grid); break; }
    }
}
```

```cpp
#include <hip/hip_runtime.h>
#include <hip/hip_cooperative_groups.h>
#include <cstdio>
#include <cstdint>
namespace cg = cooperative_groups;
namespace pg8 {
#define PG8_LAS __attribute__((address_space(3)))
typedef unsigned short bf16_t;
typedef short bf16x8 __attribute__((ext_vector_type(8)));
typedef float f32x4 __attribute__((ext_vector_type(4)));
typedef unsigned u32x4 __attribute__((ext_vector_type(4)));
constexpr int BM = 256, BK = 64, HALF = 128, HTB = HALF * BK * 2  , STAGE_BYTES = 8 * HTB, NXCD = 8, WGM = 8;

__host__ __device__ __forceinline__ int lds_byte(int r, int c) { const int st = (r >> 4) * 2 + (c >> 5), rr = r & 15, cc = c & 31, ob = rr * 64 + cc * 2; return st * 1024 + (ob ^ (((ob >> 9) & 1) << 5)); }
__host__ __device__ __forceinline__ void stage_rc(int b, int& R, int& C) { const int st = b / 1024, sb = b % 1024, swz = sb ^ (((sb >> 9) & 1) << 5); R = (st >> 1) * 16 + swz / 64; C = (st & 1) * 32 + (swz % 64) / 2; }
__host__ __device__ __forceinline__ int perm32(int rho) { const int n = rho >> 4, i = rho & 15; return 8 * (i >> 2) + 4 * n + (i & 3); }

struct Unit { int pm, pn; };
struct Gemm { const bf16_t* A; const bf16_t* Bt; int M, N, K; };

struct StaticOrder {
    int nM, nN, nwg, G, c;
    __host__ __device__ void init(int M, int N, int G_, int c_) { nM = M / BM; nN = N / BM; nwg = nM * nN; G = G_; c = c_; }
    __host__ __device__ bool next(int i, Unit& u) const {
        const long L = (long)i * G + c; if (L >= nwg) return false;
        int wgid = (int)L; { const int q = nwg / NXCD, r = nwg % NXCD, xcd = wgid % NXCD, off = wgid / NXCD; wgid = (xcd < r ? xcd * (q + 1) : r * (q + 1) + (xcd - r) * q) + off; }
        const int nig = WGM * nN, gid = wgid / nig, fm = gid * WGM, gsz = (nM - fm) < WGM ? (nM - fm) : WGM;
        u.pm = fm + ((wgid % nig) % gsz); u.pn = (wgid % nig) / gsz; return true;
    }
    __device__ __forceinline__ void a_ready(const Unit&) const {}
    __device__ __forceinline__ void done(const Unit&) const {}
};

__device__ __forceinline__ unsigned cvt_pk_bf16(float lo, float hi) { unsigned r; asm volatile("v_cvt_pk_bf16_f32 %0, %1, %2" : "=v"(r) : "v"(lo), "v"(hi)); return r; }
typedef float f32x2 __attribute__((ext_vector_type(2)));
typedef unsigned u32x2 __attribute__((ext_vector_type(2)));
constexpr float RMS_EPS = 1e-6f;
struct EpiProj {
    static constexpr bool PERM = true, AFTER_DRAIN = false;
    bf16_t* O; int ldc; const float* ssq;
    __device__ __forceinline__ void operator()(const f32x4 (&acc)[2][2][4][2], const Unit& u, int wr, int wc, int fr, int fq) const {
        const int row0 = u.pm * BM + wr * 64 + fr, col0 = u.pn * BM + wc * 32 + 8 * fq;
#pragma unroll
        for (int ai = 0; ai < 2; ++ai)
#pragma unroll
            for (int m = 0; m < 4; ++m) { const int row = row0 + ai * HALF + m * 16; const float rs = __builtin_amdgcn_rsqf(ssq[row] * (1.0f / 1024.0f) + RMS_EPS);
                bf16_t* rowp = O + (size_t)row * ldc + col0;
#pragma unroll
                for (int bj = 0; bj < 2; ++bj) { const f32x4 v0 = acc[ai][bj][m][0] * rs, v1 = acc[ai][bj][m][1] * rs;
                    u32x4 w; w.x = cvt_pk_bf16(v0[0], v0[1]); w.y = cvt_pk_bf16(v0[2], v0[3]); w.z = cvt_pk_bf16(v1[0], v1[1]); w.w = cvt_pk_bf16(v1[2], v1[3]);
                    *(u32x4*)(rowp + bj * HALF) = w; } }
    }
};
struct EpiSwiglu {
    static constexpr bool PERM = true, AFTER_DRAIN = false;
    bf16_t* O; int ldc; const float* ssq;
    __device__ __forceinline__ void operator()(const f32x4 (&acc)[2][2][4][2], const Unit& u, int wr, int wc, int fr, int fq) const {
        const int row0 = u.pm * BM + wr * 64 + fr, col0 = u.pn * HALF + wc * 32 + 8 * fq;
#pragma unroll
        for (int ai = 0; ai < 2; ++ai)
#pragma unroll
            for (int m = 0; m < 4; ++m) { const int row = row0 + ai * HALF + m * 16; const float rs = __builtin_amdgcn_rsqf(ssq[row] * (1.0f / 1024.0f) + RMS_EPS);
                float hv[8];
#pragma unroll
                for (int n = 0; n < 2; ++n)
#pragma unroll
                    for (int j = 0; j < 4; ++j) { const float g = acc[ai][0][m][n][j] * rs, up = acc[ai][1][m][n][j] * rs;
                        const float sg = g * __builtin_amdgcn_rcpf(1.0f + __builtin_amdgcn_exp2f(-1.4426950408889634f * g)); hv[n * 4 + j] = sg * up; }
                u32x4 w; w.x = cvt_pk_bf16(hv[0], hv[1]); w.y = cvt_pk_bf16(hv[2], hv[3]); w.z = cvt_pk_bf16(hv[4], hv[5]); w.w = cvt_pk_bf16(hv[6], hv[7]);
                *(u32x4*)(O + (size_t)row * ldc + col0) = w; }
    }
};
struct EpiRes {
    static constexpr bool PERM = true, AFTER_DRAIN = false;
    bf16_t* xb; float* out; float* ssq;
    __device__ __forceinline__ void operator()(const f32x4 (&acc)[2][2][4][2], const Unit& u, int wr, int wc, int fr, int fq) const {
        const int row0 = u.pm * BM + wr * 64 + fr, col0 = u.pn * BM + wc * 32 + 8 * fq;
#pragma unroll
        for (int ai = 0; ai < 2; ++ai)
#pragma unroll
            for (int m = 0; m < 4; ++m) { const int row = row0 + ai * HALF + m * 16; const size_t off = (size_t)row * 1024 + col0; float part = 0.f;
#pragma unroll
                for (int bj = 0; bj < 2; ++bj) { const size_t o = off + bj * HALF; const u32x4 rb = *(const u32x4*)(xb + o);
                    f32x4 v0, v1;
                    v0[0] = __uint_as_float(rb.x << 16) + acc[ai][bj][m][0][0]; v0[1] = __uint_as_float(rb.x & 0xffff0000u) + acc[ai][bj][m][0][1];
                    v0[2] = __uint_as_float(rb.y << 16) + acc[ai][bj][m][0][2]; v0[3] = __uint_as_float(rb.y & 0xffff0000u) + acc[ai][bj][m][0][3];
                    v1[0] = __uint_as_float(rb.z << 16) + acc[ai][bj][m][1][0]; v1[1] = __uint_as_float(rb.z & 0xffff0000u) + acc[ai][bj][m][1][1];
                    v1[2] = __uint_as_float(rb.w << 16) + acc[ai][bj][m][1][2]; v1[3] = __uint_as_float(rb.w & 0xffff0000u) + acc[ai][bj][m][1][3];
                    if (out) { *(f32x4*)(out + o) = v0; *(f32x4*)(out + o + 4) = v1; }
                    else { part += ((v0[0] * v0[0] + v0[1] * v0[1]) + (v0[2] * v0[2] + v0[3] * v0[3])) + ((v1[0] * v1[0] + v1[1] * v1[1]) + (v1[2] * v1[2] + v1[3] * v1[3]));
                        u32x4 w; w.x = cvt_pk_bf16(v0[0], v0[1]); w.y = cvt_pk_bf16(v0[2], v0[3]); w.z = cvt_pk_bf16(v1[0], v1[1]); w.w = cvt_pk_bf16(v1[2], v1[3]); *(u32x4*)(xb + o) = w; } }
                if (!out) { part += __shfl_xor(part, 16); part += __shfl_xor(part, 32);
                    if (fq == 0) __hip_atomic_fetch_add(ssq + row, part, __ATOMIC_RELAXED, __HIP_MEMORY_SCOPE_AGENT); } }
    }
};
template <class Epi, class Sched, bool ALIGN_EPI = false, bool SP2 = false>
__device__ __forceinline__ void gemm_phase(PG8_LAS unsigned char* lds, const Gemm g, const Sched& S, const Epi& E, const int tid_in) {
    const int tid = tid_in, wid = __builtin_amdgcn_readfirstlane(tid >> 6), lane = tid & 63, wr = wid >> 2, wc = wid & 3, fr = lane & 15, fq = lane >> 4;
    const int K = g.K, nt = K / BK;
    unsigned voffA[2], voffB[2];
#pragma unroll
    for (int i = 0; i < 2; ++i) { int R, C; stage_rc(tid * 16 + i * 8192, R, C); const int Rb = Epi::PERM ? ((R & ~31) + perm32(R & 31)) : R;
        voffA[i] = (unsigned)(R * K + C) * 2u; voffB[i] = (unsigned)(Rb * K + C) * 2u; }
    const size_t kstep = (size_t)(BK * 2);
    const size_t hstep = (size_t)HALF * K * 2;
    const size_t tstep = 2 * hstep;
    const unsigned ldsw = (unsigned)wid * 1024u;
    const int aoff = lds_byte(wr * 64 + fr, fq * 8), boff = lds_byte(wc * 32 + fr, fq * 8);
#define PG8_SA(b, h) (((b) * 2 + (h)) * HTB)
#define PG8_SB(b, h) ((4 + (b) * 2 + (h)) * HTB)
#define PG8_STAGE(bufoff, gbase, voff) do { _Pragma("unroll") for (int _i = 0; _i < 2; ++_i) \
        __builtin_amdgcn_global_load_lds((const unsigned*)((const char*)(gbase) + (voff)[_i]), (PG8_LAS unsigned*)(lds + (bufoff) + ldsw + _i * 8192), 16, 0, 0); } while (0)
#define PG8_LDA(dst, b, h) do { _Pragma("unroll") for (int m = 0; m < 4; ++m) _Pragma("unroll") for (int k = 0; k < 2; ++k) dst[m][k] = *(const PG8_LAS bf16x8*)(lds + PG8_SA(b, h) + aoff + m * 2048 + k * 1024); } while (0)
#define PG8_LDB(dst, b, h) do { _Pragma("unroll") for (int n = 0; n < 2; ++n) _Pragma("unroll") for (int k = 0; k < 2; ++k) dst[n][k] = *(const PG8_LAS bf16x8*)(lds + PG8_SB(b, h) + boff + n * 2048 + k * 1024); } while (0)
#define PG8_MMA(ai, bj, At, Bt) do { __builtin_amdgcn_s_setprio(1); _Pragma("unroll") for (int m = 0; m < 4; ++m) _Pragma("unroll") for (int n = 0; n < 2; ++n) _Pragma("unroll") for (int k = 0; k < 2; ++k) \
        acc[ai][bj][m][n] = __builtin_amdgcn_mfma_f32_16x16x32_bf16(Bt[n][k], At[m][k], acc[ai][bj][m][n], 0, 0, 0); __builtin_amdgcn_s_setprio(0); } while (0)
#define PG8_WAIT_V(n) asm volatile("s_waitcnt vmcnt(" #n ")" ::: "memory")
#define PG8_WAIT_L(n) asm volatile("s_waitcnt lgkmcnt(" #n ")" ::: "memory")
#define PG8_BAR __builtin_amdgcn_s_barrier()
#define PG8_SCHED __builtin_amdgcn_sched_barrier(0)
    Unit cur, nxt; int ui = 0;
    if (!S.next(0, cur)) return;
    f32x4 acc[2][2][4][2];
#pragma unroll
    for (int a = 0; a < 2; ++a)
#pragma unroll
        for (int b = 0; b < 2; ++b)
#pragma unroll
            for (int m = 0; m < 4; ++m)
#pragma unroll
                for (int n = 0; n < 2; ++n) acc[a][b][m][n] = (f32x4){0.f, 0.f, 0.f, 0.f};
    bf16x8 At[4][2], B0[2][2], B1[2][2];
    const char* cA = (const char*)g.A + (size_t)cur.pm * tstep; const char* cB = (const char*)g.Bt + (size_t)cur.pn * tstep;
    S.a_ready(cur);
    if constexpr (SP2) {
        PG8_STAGE(PG8_SB(0, 0), cB, voffB); PG8_STAGE(PG8_SB(0, 1), cB + hstep, voffB); PG8_STAGE(PG8_SA(0, 0), cA, voffA); PG8_STAGE(PG8_SA(0, 1), cA + hstep, voffA);
        if (wr == 1) PG8_BAR;
        PG8_WAIT_V(2); PG8_BAR;
        PG8_STAGE(PG8_SB(1, 0), cB + kstep, voffB); PG8_STAGE(PG8_SA(1, 0), cA + kstep, voffA); PG8_STAGE(PG8_SB(1, 1), cB + hstep + kstep, voffB);
        PG8_WAIT_V(6); PG8_BAR;
    } else {
        PG8_STAGE(PG8_SB(0, 0), cB, voffB); PG8_STAGE(PG8_SA(0, 0), cA, voffA); PG8_STAGE(PG8_SB(0, 1), cB + hstep, voffB); PG8_STAGE(PG8_SA(0, 1), cA + hstep, voffA);
        if (wr == 1) PG8_BAR;
        PG8_WAIT_V(4); PG8_BAR;
        PG8_STAGE(PG8_SB(1, 0), cB + kstep, voffB); PG8_STAGE(PG8_SA(1, 0), cA + kstep, voffA); PG8_STAGE(PG8_SB(1, 1), cB + hstep + kstep, voffB);
        PG8_WAIT_V(6); PG8_BAR;
    }
    for (;;) {
        const bool has_next = S.next(ui + 1, nxt);
        const char* nA = has_next ? (const char*)g.A + (size_t)nxt.pm * tstep : cA; const char* nB = has_next ? (const char*)g.Bt + (size_t)nxt.pn * tstep : cB;
        for (int t = 0; t < nt; t += 2) {
            const bool last = (t == nt - 2);
            const char* a1 = cA + (size_t)(t + 1) * kstep;
            const char* a2 = last ? nA : cA + (size_t)(t + 2) * kstep; const char* b2 = last ? nB : cB + (size_t)(t + 2) * kstep;
            const char* a3 = a2 + kstep; const char* b3 = b2 + kstep;
            if (last && has_next) S.a_ready(nxt);
            if constexpr (SP2) {
            PG8_LDB(B0, 0, 0); PG8_LDB(B1, 0, 1); PG8_SCHED; PG8_LDA(At, 0, 0); PG8_STAGE(PG8_SA(1, 1), a1 + hstep, voffA);
            PG8_WAIT_V(8); PG8_WAIT_L(0); PG8_BAR; PG8_MMA(0, 0, At, B0); PG8_MMA(0, 1, At, B1); PG8_BAR; PG8_SCHED;
            PG8_LDA(At, 0, 1); PG8_STAGE(PG8_SB(0, 0), b2, voffB); PG8_STAGE(PG8_SB(0, 1), b2 + hstep, voffB); PG8_STAGE(PG8_SA(0, 0), a2, voffA);
            PG8_WAIT_V(8); PG8_WAIT_L(0); PG8_BAR; PG8_MMA(1, 0, At, B0); PG8_MMA(1, 1, At, B1); PG8_BAR; PG8_SCHED;
            PG8_LDB(B0, 1, 0); PG8_LDB(B1, 1, 1); PG8_SCHED; PG8_LDA(At, 1, 0); PG8_STAGE(PG8_SA(0, 1), a2 + hstep, voffA);
            PG8_WAIT_V(8); PG8_WAIT_L(0); PG8_BAR; PG8_MMA(0, 0, At, B0); PG8_MMA(0, 1, At, B1); PG8_BAR; PG8_SCHED;
            PG8_LDA(At, 1, 1); PG8_STAGE(PG8_SB(1, 0), b3, voffB); PG8_STAGE(PG8_SB(1, 1), b3 + hstep, voffB); PG8_STAGE(PG8_SA(1, 0), a3, voffA);
            PG8_WAIT_V(8); PG8_WAIT_L(0); PG8_BAR; PG8_MMA(1, 0, At, B0); PG8_MMA(1, 1, At, B1); PG8_BAR; PG8_SCHED;
            } else {
            PG8_LDB(B0, 0, 0); PG8_SCHED; PG8_LDA(At, 0, 0); PG8_STAGE(PG8_SA(1, 1), a1 + hstep, voffA);
            PG8_WAIT_L(8); PG8_BAR; PG8_WAIT_L(0); PG8_MMA(0, 0, At, B0); PG8_BAR; PG8_SCHED;
            PG8_LDB(B1, 0, 1); PG8_STAGE(PG8_SB(0, 0), b2, voffB);
            PG8_BAR; PG8_WAIT_L(0); PG8_MMA(0, 1, At, B1); PG8_BAR;
            PG8_LDA(At, 0, 1); PG8_STAGE(PG8_SA(0, 0), a2, voffA);
            PG8_BAR; PG8_WAIT_L(0); PG8_MMA(1, 0, At, B0); PG8_BAR; PG8_SCHED;
            PG8_STAGE(PG8_SB(0, 1), b2 + hstep, voffB);
            PG8_WAIT_V(6); PG8_BAR; PG8_MMA(1, 1, At, B1); PG8_BAR;
            PG8_LDB(B0, 1, 0); PG8_SCHED; PG8_LDA(At, 1, 0); PG8_STAGE(PG8_SA(0, 1), a2 + hstep, voffA);
            PG8_WAIT_L(8); PG8_BAR; PG8_WAIT_L(0); PG8_MMA(0, 0, At, B0); PG8_BAR; PG8_SCHED;
            PG8_LDB(B1, 1, 1); PG8_STAGE(PG8_SB(1, 0), b3, voffB);
            PG8_BAR; PG8_WAIT_L(0); PG8_MMA(0, 1, At, B1); PG8_BAR;
            PG8_LDA(At, 1, 1); PG8_STAGE(PG8_SA(1, 0), a3, voffA);
            PG8_BAR; PG8_WAIT_L(0); PG8_MMA(1, 0, At, B0); PG8_BAR; PG8_SCHED;
            PG8_STAGE(PG8_SB(1, 1), b3 + hstep, voffB);
            PG8_WAIT_V(6); PG8_BAR; PG8_MMA(1, 1, At, B1); PG8_BAR;
            }
        }
        if constexpr (ALIGN_EPI) { if (wr == 0) PG8_BAR; }
        if constexpr (!Epi::AFTER_DRAIN) { E(acc, cur, wr, wc, fr, fq); S.done(cur); }
        if (!has_next) break;
#pragma unroll
        for (int a = 0; a < 2; ++a)
#pragma unroll
            for (int b = 0; b < 2; ++b)
#pragma unroll
                for (int m = 0; m < 4; ++m)
#pragma unroll
                    for (int n = 0; n < 2; ++n) acc[a][b][m][n] = (f32x4){0.f, 0.f, 0.f, 0.f};
        cur = nxt; cA = nA; cB = nB; ++ui;
        if constexpr (ALIGN_EPI) { if (wr == 1) PG8_BAR; }
    }
    PG8_WAIT_V(0);
    if constexpr (!ALIGN_EPI) { if (wr == 0) PG8_BAR; }
    PG8_BAR;
    if constexpr (Epi::AFTER_DRAIN) { E.fused(acc, cur, wr, wc, fr, fq, lds, wid, lane); S.done(cur); }
#undef PG8_SA
#undef PG8_SB
#undef PG8_STAGE
#undef PG8_LDA
#undef PG8_LDB
#undef PG8_MMA
#undef PG8_WAIT_V
#undef PG8_WAIT_L
#undef PG8_BAR
#undef PG8_SCHED
}
}

constexpr int BATCH = 2, SEQ = 8192, DM = 1024, DEPTH = 2;
constexpr int M = BATCH * SEQ;
constexpr int NPROJ = 3584, FF = 2816, NGU = 2 * FF;
constexpr int RH = 8, CH = 128, NCH = SEQ / CH;
constexpr int C_RQ = 0, C_RK = 512, C_RV = 1024, C_RG = 1536, C_DQ = 2048, C_DK = 2560, C_DV = 3072;
constexpr float EPS = 1e-6f, LOG2E = 1.4426950408889634f;
constexpr size_t MiB = 1u << 20;
constexpr size_t WS_CTL = 0, CTL_BYTES = 1 * MiB;
constexpr size_t WS_WIN = 1 * MiB, WS_WOUT = 15 * MiB, WS_WGU = 19 * MiB, WS_WDN = 41 * MiB;
constexpr size_t WS_XB = 52 * MiB;
constexpr size_t WS_MIX = 84 * MiB, WS_PROJ = 116 * MiB, WS_HID = 116 * MiB, WS_RF = 228 * MiB, WS_RB = 236 * MiB, WS_END = 244 * MiB;
constexpr size_t PAR_OFF = 512 * 1024, BAR_OFF = 768 * 1024;
constexpr int LDS_MISC = 131072;
constexpr int LDS_BYTES = 135168;
constexpr int NWAVES = 8;

#define LAS __attribute__((address_space(3)))
typedef unsigned short bf16;
typedef short bf16x8 __attribute__((ext_vector_type(8)));
typedef short s16x4 __attribute__((ext_vector_type(4)));
typedef short v4i16_t __attribute__((ext_vector_type(4)));
typedef float f32x4 __attribute__((ext_vector_type(4)));
typedef float f32x16 __attribute__((ext_vector_type(16)));
typedef unsigned u32x4 __attribute__((ext_vector_type(4)));
typedef float f32x2_t __attribute__((ext_vector_type(2)));
typedef __bf16 bf16x2_t __attribute__((ext_vector_type(2)));

__device__ __forceinline__ unsigned pk2(float lo, float hi) { f32x2_t v = {lo, hi}; bf16x2_t b = __builtin_convertvector(v, bf16x2_t); return __builtin_bit_cast(unsigned, b); }
__device__ __forceinline__ float bf2f(unsigned short b) { return __uint_as_float((unsigned)b << 16); }
__device__ __forceinline__ float bflo(unsigned w) { return __uint_as_float(w << 16); }
__device__ __forceinline__ float bfhi(unsigned w) { return __uint_as_float(w & 0xffff0000u); }
__device__ __forceinline__ int crow(int r, int hi) { return (r & 3) + 8 * (r >> 2) + 4 * hi; }
__device__ __forceinline__ s16x4 vtr(const LAS unsigned char* p) { return __builtin_bit_cast(s16x4, __builtin_amdgcn_ds_read_tr16_b64_v4i16((LAS v4i16_t*)p)); }
__device__ __forceinline__ bf16x8 cat8(s16x4 lo, s16x4 hi) { return (bf16x8){lo[0], lo[1], lo[2], lo[3], hi[0], hi[1], hi[2], hi[3]}; }
__device__ __forceinline__ void glds16(const void* g, LAS unsigned char* l) { __builtin_amdgcn_global_load_lds((const unsigned*)g, (LAS unsigned*)l, 16, 0, 0); }
__device__ __forceinline__ void glds16a(const void* g, unsigned lds_dst) { unsigned keep; asm volatile("s_mov_b32 %0, m0\n\ts_mov_b32 m0, %2\n\ts_nop 0\n\tglobal_load_lds_dwordx4 %1, off\n\ts_mov_b32 m0, %0" : "=&s"(keep) : "v"(g), "s"(lds_dst) : "memory"); }
#define MFMA32(a, b, c) __builtin_amdgcn_mfma_f32_32x32x16_bf16((a), (b), (c), 0, 0, 0)
#define VMWAIT0() asm volatile("s_waitcnt vmcnt(0)" ::: "memory")
__device__ __forceinline__ float wave_sum(float v) {
#pragma unroll
    for (int o = 1; o < 64; o <<= 1) v += __shfl_xor(v, o);
    return v;
}
__device__ __forceinline__ float half_sum32(float v) {
#pragma unroll
    for (int o = 1; o < 32; o <<= 1) v += __shfl_xor(v, o);
    return v;
}

struct Params { float lam[DEPTH]; float b2[DEPTH]; };

__device__ __forceinline__ void transpose_item(const float* W, int K, int N, bf16* WT, const float* gk, int rowmap, LAS float* scr, int item, int lane) {
    const int nblk = N / 32, kb = item / nblk, nb = item % nblk, k0 = 64 * kb, n0 = 32 * nb;
#pragma unroll 8
    for (int i = 0; i < 32; ++i) { const int kk = 2 * i + (lane >> 5); scr[kk * 33 + (lane & 31)] = W[(size_t)(k0 + kk) * N + n0 + (lane & 31)]; }
    asm volatile("s_waitcnt lgkmcnt(0)" ::: "memory");
    const int c = lane & 7;
    float g8[8];
#pragma unroll
    for (int i = 0; i < 8; ++i) g8[i] = gk ? gk[k0 + 8 * c + i] : 1.0f;
    const int r0 = rowmap == 0 ? n0 : ((n0 >> 7) * 256 + (n0 & 127) + (rowmap == 2 ? 128 : 0));
#pragma unroll
    for (int j = 0; j < 4; ++j) { const int n = (lane >> 3) + 8 * j; const LAS float* s = scr + (8 * c) * 33 + n;
        u32x4 o; o.x = pk2(s[0 * 33] * g8[0], s[1 * 33] * g8[1]); o.y = pk2(s[2 * 33] * g8[2], s[3 * 33] * g8[3]); o.z = pk2(s[4 * 33] * g8[4], s[5 * 33] * g8[5]); o.w = pk2(s[6 * 33] * g8[6], s[7 * 33] * g8[7]);
        *(u32x4*)(WT + (size_t)(r0 + n) * K + k0 + 8 * c) = o; }
    asm volatile("s_waitcnt lgkmcnt(0)" ::: "memory");
}
__device__ __forceinline__ void row_to_bf16_ssq(const float* xrow, bf16* orow, float* ssq, int lane) {
    const f32x4* xr = (const f32x4*)xrow + lane;
    f32x4 v[4]; float s = 0.f;
#pragma unroll
    for (int j = 0; j < 4; ++j) { v[j] = xr[64 * j]; s += (v[j].x * v[j].x + v[j].y * v[j].y) + (v[j].z * v[j].z + v[j].w * v[j].w); }
    s = wave_sum(s);
    unsigned long long* o8 = (unsigned long long*)orow + lane;
#pragma unroll
    for (int j = 0; j < 4; ++j) o8[64 * j] = (unsigned long long)pk2(v[j].x, v[j].y) | ((unsigned long long)pk2(v[j].z, v[j].w) << 32);
    if (lane == 0) *ssq = s;
}

struct Args { const float* in[18]; float* out; unsigned char* ws; int ph_lo, ph_hi; };
struct Frame {
    LAS unsigned char* lds;
    float* out; unsigned char* ws;
    int tid, lane, wave, vcu, G;
};

__device__ __forceinline__ void p0_prologue(Frame& F, const Args& A) {
    LAS float* scr = (LAS float*)(F.lds + F.wave * 16384);
    const int gw = F.vcu * NWAVES + F.wave, NGW = F.G * NWAVES;
    constexpr int I_IN = (DM / 64) * (NPROJ / 32), I_OUT = (DM / 64) * (DM / 32), I_G = (DM / 64) * (FF / 32), I_D = (FF / 64) * (DM / 32);
    constexpr int PER_LAYER = I_IN + I_OUT + 2 * I_G + I_D;
    for (int it = gw; it < DEPTH * PER_LAYER; it += NGW) {
        const int l = it / PER_LAYER; int r = it % PER_LAYER;
        const float* g_attn = A.in[1] + l * DM; const float* g_ffn = A.in[14] + l * DM;
        if (r < I_IN) { transpose_item(A.in[2] + (size_t)l * DM * NPROJ, DM, NPROJ, (bf16*)(F.ws + WS_WIN) + (size_t)l * NPROJ * DM, g_attn, 0, scr, r, F.lane); continue; } r -= I_IN;
        if (r < I_OUT) { transpose_item(A.in[13] + (size_t)l * DM * DM, DM, DM, (bf16*)(F.ws + WS_WOUT) + (size_t)l * DM * DM, nullptr, 0, scr, r, F.lane); continue; } r -= I_OUT;
        if (r < I_G) { transpose_item(A.in[15] + (size_t)l * DM * FF, DM, FF, (bf16*)(F.ws + WS_WGU) + (size_t)l * NGU * DM, g_ffn, 1, scr, r, F.lane); continue; } r -= I_G;
        if (r < I_G) { transpose_item(A.in[16] + (size_t)l * DM * FF, DM, FF, (bf16*)(F.ws + WS_WGU) + (size_t)l * NGU * DM, g_ffn, 2, scr, r, F.lane); continue; } r -= I_G;
        transpose_item(A.in[17] + (size_t)l * FF * DM, FF, DM, (bf16*)(F.ws + WS_WDN) + (size_t)l * DM * FF, nullptr, 0, scr, r, F.lane);
    }
    float* ssq0 = (float*)(F.ws + WS_CTL);
    for (int m = gw; m < M; m += NGW) row_to_bf16_ssq(A.in[0] + (size_t)m * DM, (bf16*)(F.ws + WS_XB) + (size_t)m * DM, ssq0 + m, F.lane);
    if (blockIdx.x == 0 && F.wave == 0) {
        Params* P = (Params*)(F.ws + WS_CTL + PAR_OFF);
        for (int l = 0; l < DEPTH; ++l) {
            const float a = wave_sum(A.in[8][l * 64 + F.lane] * A.in[9][l * 64 + F.lane]), b = wave_sum(A.in[10][l * 64 + F.lane] * A.in[11][l * 64 + F.lane]);
            const float lam_init = 0.8f - 0.6f * expf(-0.3f * (float)l);
            if (F.lane == 0) P->lam[l] = expf(a) - expf(b) + lam_init;
            float gq = fabsf(A.in[6][l * 64 + F.lane]), gk = fabsf(A.in[7][l * 64 + F.lane]);
#pragma unroll
            for (int o = 1; o < 64; o <<= 1) { gq = fmaxf(gq, __shfl_xor(gq, o)); gk = fmaxf(gk, __shfl_xor(gk, o)); }
            if (F.lane == 0) P->b2[l] = 8.0f * LOG2E * 1.02f * gq * gk;
        }
    }
}

__device__ __forceinline__ void qknorm_pass(Frame& F, const Args& A, int l) {
    bf16* PROJ = (bf16*)(F.ws + WS_PROJ);
    const int c = F.tid & 127, sub = F.tid >> 7;
    const bool isq = c < 64; const int d0 = (8 * c) & 63;
    const float* g = (isq ? A.in[6] : A.in[7]) + l * 64 + d0; const float sc = isq ? 0.125f * LOG2E : 1.0f;
    float g8[8];
#pragma unroll
    for (int i = 0; i < 8; ++i) g8[i] = g[i] * sc;
    for (int it = F.vcu; it < M / 4; it += F.G) {
        const int row = 4 * it + sub; u32x4* p = (u32x4*)(PROJ + (size_t)row * NPROJ + C_DQ + 8 * c);
        const u32x4 w = *p; float x[8] = {bflo(w.x), bfhi(w.x), bflo(w.y), bfhi(w.y), bflo(w.z), bfhi(w.z), bflo(w.w), bfhi(w.w)};
        float ss = 0.f;
#pragma unroll
        for (int i = 0; i < 8; ++i) ss += x[i] * x[i];
        ss += __shfl_xor(ss, 1); ss += __shfl_xor(ss, 2); ss += __shfl_xor(ss, 4);
        const float r = __builtin_amdgcn_rsqf(ss * (1.0f / 64.0f) + EPS);
        u32x4 o; o.x = pk2(x[0] * r * g8[0], x[1] * r * g8[1]); o.y = pk2(x[2] * r * g8[2], x[3] * r * g8[3]); o.z = pk2(x[4] * r * g8[4], x[5] * r * g8[5]); o.w = pk2(x[6] * r * g8[6], x[7] * r * g8[7]);
        *p = o;
    }
}
__device__ __forceinline__ int tr_off128(int lane, int r0, int cb) { return (r0 + ((lane & 15) >> 2)) * 128 + (32 * cb + 16 * ((lane >> 4) & 1)) * 2 + 8 * (lane & 3); }

__device__ __forceinline__ void ret_kv_item(Frame& F, const Args& A, int l, int item) {
    const bf16* PROJ = (const bf16*)(F.ws + WS_PROJ);
    const int n = item & 63, h = (item >> 6) & 7, b = item >> 9;
    int lane_ = F.lane; asm volatile("" : "+v"(lane_));
    const int tid_ = (F.wave << 6) | lane_;
    const float lgf2 = -expf(A.in[3][l * RH + h]) * LOG2E, lgb2 = -expf(A.in[4][l * RH + h]) * LOG2E;
    const size_t row0 = (size_t)b * SEQ + (size_t)n * CH;
    LAS unsigned char* LK = F.lds; LAS unsigned char* LVF = F.lds + 16384; LAS unsigned char* LVB = F.lds + 32768;
#pragma unroll
    for (int i = 0; i < 2; ++i) { const int pc = tid_ + 512 * i, s = pc >> 3, ch = pc & 7;
        const u32x4 kw = *(const u32x4*)(PROJ + (row0 + s) * NPROJ + C_RK + h * 64 + 8 * ch);
        const u32x4 vw = *(const u32x4*)(PROJ + (row0 + s) * NPROJ + C_RV + h * 64 + 8 * ch);
        *(LAS u32x4*)(LK + s * 128 + ch * 16) = kw;
        const float wf = __builtin_amdgcn_exp2f(lgf2 * (float)(CH - 1 - s)) * 0.125f, wb = __builtin_amdgcn_exp2f(lgb2 * (float)s) * 0.125f;
        const float x[8] = {bflo(vw.x), bfhi(vw.x), bflo(vw.y), bfhi(vw.y), bflo(vw.z), bfhi(vw.z), bflo(vw.w), bfhi(vw.w)};
        u32x4 a, c2;
        a.x = pk2(x[0] * wf, x[1] * wf); a.y = pk2(x[2] * wf, x[3] * wf); a.z = pk2(x[4] * wf, x[5] * wf); a.w = pk2(x[6] * wf, x[7] * wf);
        c2.x = pk2(x[0] * wb, x[1] * wb); c2.y = pk2(x[2] * wb, x[3] * wb); c2.z = pk2(x[4] * wb, x[5] * wb); c2.w = pk2(x[6] * wb, x[7] * wb);
        *(LAS u32x4*)(LVF + s * 128 + ch * 16) = a; *(LAS u32x4*)(LVB + s * 128 + ch * 16) = c2; }
    __syncthreads();
    const int dir = F.wave >> 2, db = (F.wave >> 1) & 1, eb = F.wave & 1, hi = lane_ >> 5;
    const LAS unsigned char* LV = dir ? LVB : LVF;
    const int tb8 = (8 * hi + ((lane_ & 15) >> 2)) * 128 + 32 * ((lane_ >> 4) & 1) + 8 * (lane_ & 3);
    const LAS unsigned char* pa = LK + tb8 + 64 * db; const LAS unsigned char* pb_ = LV + tb8 + 64 * eb;
    f32x16 acc = {};
#pragma unroll
    for (int st = 0; st < 8; ++st) {
        const bf16x8 a = cat8(vtr(pa + st * 2048), vtr(pa + st * 2048 + 512));
        const bf16x8 bb = cat8(vtr(pb_ + st * 2048), vtr(pb_ + st * 2048 + 512));
        acc = MFMA32(a, bb, acc);
    }
    float* KV = (float*)((unsigned char*)F.out + (dir ? 16 * MiB : 0)) + (size_t)item * 4096;
#pragma unroll
    for (int r = 0; r < 16; ++r) KV[(32 * db + crow(r, hi)) * 64 + 32 * eb + (lane_ & 31)] = acc[r];
    __syncthreads();
}

__device__ __forceinline__ void ret_scan(Frame& F, const Args& A, int l) {
    const int total = 2 * BATCH * RH * 4096;
    for (int gid = F.vcu * 512 + F.tid; gid < total; gid += F.G * 512) {
        const int dir = gid / (BATCH * RH * 4096), rem = gid % (BATCH * RH * 4096), bh = rem >> 12, el = rem & 4095, h = bh & 7;
        const float lg = -expf((dir ? A.in[4] : A.in[3])[l * RH + h]); const float dc = expf(lg * (float)CH);
        const float* KV = (const float*)((unsigned char*)F.out + (dir ? 16 * MiB : 0)) + (size_t)bh * NCH * 4096 + el;
        bf16* R = (bf16*)(F.ws + (dir ? WS_RB : WS_RF)) + (size_t)bh * NCH * 4096 + el;
        float st = 0.f;
        if (dir == 0) {
#pragma unroll 8
            for (int n = 0; n < NCH; ++n) { const float kv = KV[(size_t)n * 4096]; R[(size_t)n * 4096] = (bf16)(pk2(st, 0.f) & 0xffffu); st = dc * st + kv; }
        } else {
#pragma unroll 8
            for (int n = NCH - 1; n >= 0; --n) { const float kv = KV[(size_t)n * 4096]; R[(size_t)n * 4096] = (bf16)(pk2(st, 0.f) & 0xffffu); st = dc * st + kv; }
        }
    }
}

__device__ __forceinline__ void attn_half(Frame& F, const Args& A, int l, int b, int h, int qb, int m) {
    const bf16* PROJ = (const bf16*)(F.ws + WS_PROJ); bf16* OB = (bf16*)((unsigned char*)F.out + 32 * MiB) + (size_t)m * M * 512;
    int lane = F.lane; asm volatile("" : "+v"(lane));
    const int r32 = lane & 31, hi = lane >> 5, wid = F.wave;
    const size_t rowbase = (size_t)b * SEQ; const int q0 = qb * 256 + wid * 32;
    const float B2 = ((const Params*)(F.ws + WS_CTL + PAR_OFF))->b2[l];
    const float slope2 = exp2f(-2.0f * (float)(h + 1)) * LOG2E, nslope2 = -slope2;
    const int dthr = (int)(150.0f / slope2) + 1;
    const int t_lo = max(0, ((qb * 256 - 63 - dthr) >> 6) + 1), t_hi = min(SEQ / 64, (qb * 256 + 255 + dthr + 63) >> 6);
    LAS unsigned char* lds = F.lds;
    LAS float* wsf = (LAS float*)(lds + 73728) + wid * 64;
    const bf16* kvb = PROJ + rowbase * NPROJ;
    const bf16* vsrc = kvb + (size_t)(16 * (wid & 3) + (lane >> 2)) * NPROJ + C_DV + h * 128 + 32 * (wid >> 2) + 8 * (lane & 3);
    const int vlane = ((lane >> 4) & 1) * 32 + (lane & 3) * 8 + (4 * hi + ((lane & 15) >> 2)) * 64;
    const int klane = (r32 >> 3) * 1024 + (r32 & 7) * 128 + ((hi ^ (r32 & 7)) << 4);
    bf16x8 qf[4];
    { const bf16* qrow = PROJ + (rowbase + q0 + r32) * NPROJ + C_DQ + h * 128 + m * 64 + hi * 8;
#pragma unroll
      for (int d0 = 0; d0 < 4; ++d0) qf[d0] = *(const bf16x8*)(qrow + d0 * 16); }
    const bf16* ksrc = kvb + (size_t)(8 * wid + (lane >> 3)) * NPROJ + C_DK + h * 128 + m * 64 + 8 * ((lane & 7) ^ (lane >> 3));
    f32x16 oa[4];
#pragma unroll
    for (int i = 0; i < 4; ++i) oa[i] = f32x16{};
    float ls = 0.f;
    const int n = t_hi - t_lo;
    const int tq = q0 >> 6;
    const unsigned ldsb = (unsigned)(uintptr_t)lds;
    const float dq0 = (float)(q0 + r32 - t_lo * 64 - 4 * hi);
#define DMA_K(i, slot) glds16a(ksrc + (size_t)min(t_lo + (i), SEQ / 64 - 1) * 64 * NPROJ, (unsigned)__builtin_amdgcn_readfirstlane((int)(ldsb + (slot) * 8192 + wid * 1024)))
#define DMA_V(i, slot) do { const bf16* v_ = vsrc + (size_t)min(t_lo + (i), SEQ / 64 - 1) * 64 * NPROJ; const unsigned d_ = (unsigned)__builtin_amdgcn_readfirstlane((int)(ldsb + 24576 + (slot) * 16384 + wid * 1024)); glds16a(v_, d_); glds16a(v_ + 64, d_ + 8192); } while (0)
#define KADDR(p, d0) ((const LAS unsigned char*)(uintptr_t)((unsigned)(uintptr_t)(p) ^ (unsigned)((d0) << 5)))
#define BIAS(S0, S1, i) do { const float dq_ = dq0 - 64.0f * (float)(i); _Pragma("unroll") for (int r = 0; r < 16; ++r) { const float c = (float)((r & 3) + 8 * (r >> 2)); \
        S0[r] = nslope2 * fabsf(dq_ - c) - B2; S1[r] = nslope2 * fabsf(dq_ - (c + 32.0f)) - B2; } } while (0)
#define QK_ACC(S0, S1, slot) do { const LAS unsigned char* kp_ = lds + (slot) * 8192 + klane; _Pragma("unroll") for (int d0 = 0; d0 < 4; ++d0) { \
        const LAS unsigned char* ka_ = KADDR(kp_, d0); const bf16x8 b0 = *(const LAS bf16x8*)(ka_); const bf16x8 b1 = *(const LAS bf16x8*)(ka_ + 4096); \
        S0 = MFMA32(b0, qf[d0], S0); S1 = MFMA32(b1, qf[d0], S1); } } while (0)
#define FENCE() __builtin_amdgcn_sched_barrier(0)
#define EXP4(C, k, s_) do { C[k] = __builtin_amdgcn_exp2f(C[k]); C[(k) + 1] = __builtin_amdgcn_exp2f(C[(k) + 1]); C[(k) + 2] = __builtin_amdgcn_exp2f(C[(k) + 2]); C[(k) + 3] = __builtin_amdgcn_exp2f(C[(k) + 3]); \
        s_ += (C[k] + C[(k) + 1]) + (C[(k) + 2] + C[(k) + 3]); } while (0)
#define PACK8(C, k) (u32x4){pk2(C[k], C[(k) + 1]), pk2(C[(k) + 2], C[(k) + 3]), pk2(C[(k) + 4], C[(k) + 5]), pk2(C[(k) + 6], C[(k) + 7])}
#define KLD(dst0, dst1, d0) do { const LAS unsigned char* ka_ = KADDR(kp_, d0); dst0 = *(const LAS bf16x8*)(ka_); dst1 = *(const LAS bf16x8*)(ka_ + 4096); } while (0)
#define VLD(dst, off) dst = cat8(vtr(vb_ + (off)), vtr(vb_ + (off) + 512))
#define BIAS4(S0, S1, k, dq_) do { if (strad_) { _Pragma("unroll") for (int r = (k); r < (k) + 4; ++r) { const float c = (float)((r & 3) + 8 * (r >> 2)); \
        S0[r] = nslope2 * fabsf(dq_ - c) - B2; S1[r] = nslope2 * fabsf(dq_ - (c + 32.0f)) - B2; } } \
      else { BIAS4F_##k(S0, S1); } } while (0)
#define FMK(dst, base, K) do { float t_; asm("v_fmamk_f32 %0, %1, " #K ", %2" : "=v"(t_) : "v"(sg_), "v"(base)); dst = t_; } while (0)
#define BIAS4F_0(S0, S1) do { FMK(S0[0], base0_, 0x00000000); FMK(S1[0], base1_, 0x00000000); FMK(S0[1], base0_, 0x3f800000); FMK(S1[1], base1_, 0x3f800000); FMK(S0[2], base0_, 0x40000000); FMK(S1[2], base1_, 0x40000000); FMK(S0[3], base0_, 0x40400000); FMK(S1[3], base1_, 0x40400000); } while (0)
#define BIAS4F_4(S0, S1) do { FMK(S0[4], base0_, 0x41000000); FMK(S1[4], base1_, 0x41000000); FMK(S0[5], base0_, 0x41100000); FMK(S1[5], base1_, 0x41100000); FMK(S0[6], base0_, 0x41200000); FMK(S1[6], base1_, 0x41200000); FMK(S0[7], base0_, 0x41300000); FMK(S1[7], base1_, 0x41300000); } while (0)
#define BIAS4F_8(S0, S1) do { FMK(S0[8], base0_, 0x41800000); FMK(S1[8], base1_, 0x41800000); FMK(S0[9], base0_, 0x41880000); FMK(S1[9], base1_, 0x41880000); FMK(S0[10], base0_, 0x41900000); FMK(S1[10], base1_, 0x41900000); FMK(S0[11], base0_, 0x41980000); FMK(S1[11], base1_, 0x41980000); } while (0)
#define BIAS4F_12(S0, S1) do { FMK(S0[12], base0_, 0x41c00000); FMK(S1[12], base1_, 0x41c00000); FMK(S0[13], base0_, 0x41c80000); FMK(S1[13], base1_, 0x41c80000); FMK(S0[14], base0_, 0x41d00000); FMK(S1[14], base1_, 0x41d00000); FMK(S0[15], base0_, 0x41d80000); FMK(S1[15], base1_, 0x41d80000); } while (0)
#define STEP(C0, C1, N0, N1, i) do { \
        DMA_K((i) + 3, r0); DMA_V((i) + 2, r2);     \
        const LAS unsigned char* kp_ = lds + r1 * 8192 + klane; \
        const LAS unsigned char* vb_ = lds + 24576 + r0 * 16384 + vlane; \
        const float dq2_ = dq0 - 64.0f * (float)((i) + 2); \
        const int tt_ = t_lo + (i) + 2; const bool strad_ = (tt_ == tq); const float sg_ = (tt_ < tq) ? slope2 : nslope2; const float base0_ = -sg_ * dq2_ - B2, base1_ = base0_ + 32.0f * sg_; \
        float s_ = 0.f; bf16x8 ka0, ka1, va, vb2, vc, vd; u32x4 pw0, pw1, pw2, pw3; \
        KLD(ka0, ka1, 0); \
        FENCE(); \
          \
        N0 = MFMA32(ka0, qf[0], N0); N1 = MFMA32(ka1, qf[0], N1); KLD(ka0, ka1, 1); EXP4(C0, 0, s_); FENCE(); \
        N0 = MFMA32(ka0, qf[1], N0); N1 = MFMA32(ka1, qf[1], N1); KLD(ka0, ka1, 2); EXP4(C0, 4, s_); pw0 = PACK8(C0, 0); FENCE(); \
        N0 = MFMA32(ka0, qf[2], N0); N1 = MFMA32(ka1, qf[2], N1); KLD(ka0, ka1, 3); EXP4(C0, 8, s_); FENCE(); \
        N0 = MFMA32(ka0, qf[3], N0); N1 = MFMA32(ka1, qf[3], N1); VLD(va, 0); VLD(vb2, 4096); EXP4(C0, 12, s_); pw1 = PACK8(C0, 8); FENCE(); \
          \
        VLD(vc, 8192); VLD(vd, 12288); oa[0] = MFMA32(__builtin_bit_cast(bf16x8, pw0), va, oa[0]); oa[1] = MFMA32(__builtin_bit_cast(bf16x8, pw0), vb2, oa[1]); EXP4(C1, 0, s_); FENCE(); \
        VLD(va, 1024); VLD(vb2, 5120); oa[2] = MFMA32(__builtin_bit_cast(bf16x8, pw0), vc, oa[2]); oa[3] = MFMA32(__builtin_bit_cast(bf16x8, pw0), vd, oa[3]); EXP4(C1, 4, s_); pw2 = PACK8(C1, 0); FENCE(); \
        VLD(vc, 9216); VLD(vd, 13312); oa[0] = MFMA32(__builtin_bit_cast(bf16x8, pw1), va, oa[0]); oa[1] = MFMA32(__builtin_bit_cast(bf16x8, pw1), vb2, oa[1]); EXP4(C1, 8, s_); FENCE(); \
        VLD(va, 2048); VLD(vb2, 6144); oa[2] = MFMA32(__builtin_bit_cast(bf16x8, pw1), vc, oa[2]); oa[3] = MFMA32(__builtin_bit_cast(bf16x8, pw1), vd, oa[3]); EXP4(C1, 12, s_); pw3 = PACK8(C1, 8); FENCE(); \
        ls += s_; \
        VLD(vc, 10240); VLD(vd, 14336); oa[0] = MFMA32(__builtin_bit_cast(bf16x8, pw2), va, oa[0]); oa[1] = MFMA32(__builtin_bit_cast(bf16x8, pw2), vb2, oa[1]); BIAS4(C0, C1, 0, dq2_); FENCE(); \
        VLD(va, 3072); VLD(vb2, 7168); oa[2] = MFMA32(__builtin_bit_cast(bf16x8, pw2), vc, oa[2]); oa[3] = MFMA32(__builtin_bit_cast(bf16x8, pw2), vd, oa[3]); BIAS4(C0, C1, 4, dq2_); FENCE(); \
        VLD(vc, 11264); VLD(vd, 15360); oa[0] = MFMA32(__builtin_bit_cast(bf16x8, pw3), va, oa[0]); oa[1] = MFMA32(__builtin_bit_cast(bf16x8, pw3), vb2, oa[1]); BIAS4(C0, C1, 8, dq2_); FENCE(); \
        oa[2] = MFMA32(__builtin_bit_cast(bf16x8, pw3), vc, oa[2]); oa[3] = MFMA32(__builtin_bit_cast(bf16x8, pw3), vd, oa[3]); BIAS4(C0, C1, 12, dq2_); FENCE(); \
        asm volatile("s_waitcnt vmcnt(3)" ::: "memory"); \
        __syncthreads(); { const int t_ = r0; r0 = r1; r1 = r2; r2 = t_; } } while (0)
    f32x16 A0, A1, B0, B1;
    if (wid >= 4) __builtin_amdgcn_s_setprio(1);
    int r0 = 0, r1 = 1, r2 = 2;
    DMA_K(0, 0); DMA_V(0, 0); DMA_K(1, 1); DMA_V(1, 1); DMA_K(2, 2);
    BIAS(A0, A1, 0);
    VMWAIT0(); __syncthreads();
    { const LAS unsigned char* kp_ = lds + klane; _Pragma("unroll") for (int d0 = 0; d0 < 4; ++d0) {
        const LAS unsigned char* ka_ = KADDR(kp_, d0); const bf16x8 b0 = *(const LAS bf16x8*)(ka_); const bf16x8 b1 = *(const LAS bf16x8*)(ka_ + 4096);
        A0 = MFMA32(b0, qf[d0], A0); A1 = MFMA32(b1, qf[d0], A1); } }
    BIAS(B0, B1, 1);
    asm volatile("s_waitcnt lgkmcnt(0)" ::: "memory"); __syncthreads();
#pragma unroll 1
    for (int i = 0;; i += 2) {
        STEP(A0, A1, B0, B1, i);
        if (i + 1 >= n) break;
        STEP(B0, B1, A0, A1, i + 1);
        if (i + 2 >= n) break;
    }
    VMWAIT0();
    __builtin_amdgcn_s_setprio(0);
#undef DMA_K
#undef DMA_V
#undef BIAS
#undef QK_ACC
#undef KADDR
#undef STEP
#undef FENCE
#undef EXP4
#undef PACK8
#undef KLD
#undef VLD
#undef BIAS4
    ls += __shfl_xor(ls, 32);
    int le = lane; asm volatile("" : "+v"(le));
    const int r32e = le & 31, hie = le >> 5;
    if (hie == 0) wsf[r32e] = 1.0f / ls;
    asm volatile("s_waitcnt lgkmcnt(0)" ::: "memory");
#pragma unroll
    for (int r = 0; r < 16; ++r) {
        const int qr = crow(r, hie); const float a1 = wsf[qr];
        bf16* orow = OB + (rowbase + q0 + qr) * 512 + h * 128 + r32e;
#pragma unroll
        for (int db = 0; db < 4; ++db) orow[32 * db] = (bf16)(pk2(oa[db][r] * a1, 0.f) & 0xffffu);
        asm volatile("" ::: "memory");
    }
    __syncthreads();
}
__device__ __forceinline__ void attn_combine(Frame& F, const Args& A, int l) {
    const bf16* OB0 = (const bf16*)((unsigned char*)F.out + 32 * MiB); const bf16* OB1 = OB0 + (size_t)M * 512; bf16* MIX = (bf16*)(F.ws + WS_MIX);
    const Params* P = (const Params*)(F.ws + WS_CTL + PAR_OFF);
    const float lam = P->lam[l], post = 1.0f - (0.8f - 0.6f * expf(-0.3f * (float)l));
    const int c16 = F.tid & 15, grp = F.tid >> 4;
    float g8[8];
#pragma unroll
    for (int i = 0; i < 8; ++i) g8[i] = A.in[12][l * 128 + 8 * c16 + i] * post;
    for (int it = F.vcu; it < M * 4 / 32; it += F.G) {
        const int gi = it * 32 + grp, row = gi >> 2, h = gi & 3;
        const size_t off = (size_t)row * 512 + h * 128 + 8 * c16;
        const u32x4 a = *(const u32x4*)(OB0 + off), bq = *(const u32x4*)(OB1 + off);
        float v[8] = {bflo(a.x) - lam * bflo(bq.x), bfhi(a.x) - lam * bfhi(bq.x), bflo(a.y) - lam * bflo(bq.y), bfhi(a.y) - lam * bfhi(bq.y),
                      bflo(a.z) - lam * bflo(bq.z), bfhi(a.z) - lam * bfhi(bq.z), bflo(a.w) - lam * bflo(bq.w), bfhi(a.w) - lam * bfhi(bq.w)};
        float ss = 0.f;
#pragma unroll
        for (int i = 0; i < 8; ++i) ss += v[i] * v[i];
        ss += __shfl_xor(ss, 1); ss += __shfl_xor(ss, 2); ss += __shfl_xor(ss, 4); ss += __shfl_xor(ss, 8);
        const float rs = __builtin_amdgcn_rsqf(ss * (1.0f / 128.0f) + EPS);
        u32x4 o; o.x = pk2(v[0] * rs * g8[0], v[1] * rs * g8[1]); o.y = pk2(v[2] * rs * g8[2], v[3] * rs * g8[3]); o.z = pk2(v[4] * rs * g8[4], v[5] * rs * g8[5]); o.w = pk2(v[6] * rs * g8[6], v[7] * rs * g8[7]);
        *(u32x4*)(MIX + (size_t)row * DM + 512 + h * 128 + 8 * c16) = o;
    }
}

__device__ __forceinline__ void ret_out_pair(Frame& F, const Args& A, int l, int pair) {
    const bf16* PROJ = (const bf16*)(F.ws + WS_PROJ); bf16* MIX = (bf16*)(F.ws + WS_MIX);
    int lane = F.lane; asm volatile("" : "+v"(lane));
    const int r32 = lane & 31, hi = lane >> 5, grp = F.wave >> 2, wq = F.wave & 3, gt = (wq << 6) | lane;
    const int item = 2 * pair + grp; const int n = item & 63, h = (item >> 6) & 7, b = item >> 9;
    const float lgf2 = -expf(A.in[3][l * RH + h]) * LOG2E, lgb2 = -expf(A.in[4][l * RH + h]) * LOG2E;
    const size_t row0 = (size_t)b * SEQ + (size_t)n * CH;
    LAS unsigned char* LK = F.lds + grp * 49152; LAS unsigned char* LV = LK + 16384; LAS unsigned char* LRF = LK + 32768; LAS unsigned char* LRB = LK + 40960;
    const bf16* RF = (const bf16*)(F.ws + WS_RF) + (size_t)item * 4096; const bf16* RB = (const bf16*)(F.ws + WS_RB) + (size_t)item * 4096;
#pragma unroll
    for (int i = 0; i < 4; ++i) { const int pc = gt + 256 * i, s = pc >> 3, ch = pc & 7;
        *(LAS u32x4*)(LV + s * 128 + ch * 16) = *(const u32x4*)(PROJ + (row0 + s) * NPROJ + C_RV + h * 64 + 8 * ch);
        *(LAS u32x4*)(LK + s * 128 + ((ch ^ (s & 7)) << 4)) = *(const u32x4*)(PROJ + (row0 + s) * NPROJ + C_RK + h * 64 + 8 * ch); }
#pragma unroll
    for (int i = 0; i < 2; ++i) { const int pc = gt + 256 * i;
        *(LAS u32x4*)(LRF + pc * 16) = *(const u32x4*)(RF + pc * 8); *(LAS u32x4*)(LRB + pc * 16) = *(const u32x4*)(RB + pc * 8); }
    const int t0 = 32 * wq;
    LAS unsigned char* GW = F.lds + 98304 + F.wave * 4096;
#pragma unroll
    for (int i = 0; i < 4; ++i) { const int pc = lane + 64 * i, rw = pc >> 3, ch = pc & 7;
        *(LAS u32x4*)(GW + rw * 128 + ch * 16) = *(const u32x4*)(PROJ + (row0 + t0 + rw) * NPROJ + C_RG + h * 64 + 8 * ch); }
    bf16x8 qf[4];
    { const bf16* qrow = PROJ + (row0 + t0 + r32) * NPROJ + C_RQ + h * 64 + hi * 8;
#pragma unroll
      for (int d0 = 0; d0 < 4; ++d0) qf[d0] = *(const bf16x8*)(qrow + d0 * 16); }
    __syncthreads();
    f32x16 X[4];
    const unsigned kb0 = (unsigned)(uintptr_t)LK + (unsigned)(r32 * 128 + ((hi ^ (r32 & 7)) << 4));
#pragma unroll
    for (int sb = 0; sb < 4; ++sb) { X[sb] = f32x16{};
#pragma unroll
        for (int d0 = 0; d0 < 4; ++d0) { const bf16x8 kf = *(const LAS bf16x8*)(uintptr_t)((kb0 + sb * 4096) ^ (unsigned)(d0 << 5)); X[sb] = MFMA32(kf, qf[d0], X[sb]); } }
    u32x4 pw[8];
    const float tf = (float)(t0 + r32);
#pragma unroll
    for (int sb = 0; sb < 4; ++sb) {
#pragma unroll
        for (int r = 0; r < 16; ++r) { const float dl = tf - (float)(32 * sb + crow(r, hi)); const float e = lgf2 * fmaxf(dl, 0.f) + lgb2 * fmaxf(-dl, 0.f); X[sb][r] *= __builtin_amdgcn_exp2f(e - 3.0f); }
        pw[2 * sb] = (u32x4){pk2(X[sb][0], X[sb][1]), pk2(X[sb][2], X[sb][3]), pk2(X[sb][4], X[sb][5]), pk2(X[sb][6], X[sb][7])};
        pw[2 * sb + 1] = (u32x4){pk2(X[sb][8], X[sb][9]), pk2(X[sb][10], X[sb][11]), pk2(X[sb][12], X[sb][13]), pk2(X[sb][14], X[sb][15])};
    }
    __builtin_amdgcn_sched_barrier(0);
    const int q4 = (lane & 15) >> 2, tcol = 32 * ((lane >> 4) & 1) + 8 * (lane & 3);
    const LAS unsigned char* pv = LV + (4 * hi + q4) * 128 + tcol;
    const LAS unsigned char* prf = LRF + (8 * hi + q4) * 128 + tcol;
    const LAS unsigned char* prb = LRB + (8 * hi + q4) * 128 + tcol;
    f32x16 aI[2], aF[2], aB[2];
#pragma unroll
    for (int eb = 0; eb < 2; ++eb) { aI[eb] = f32x16{};
#pragma unroll
        for (int ks = 0; ks < 8; ++ks) {
            const bf16x8 vf = cat8(vtr(pv + ks * 2048 + 64 * eb), vtr(pv + ks * 2048 + 1024 + 64 * eb));
            aI[eb] = MFMA32(__builtin_bit_cast(bf16x8, pw[ks]), vf, aI[eb]); } }
    __builtin_amdgcn_sched_barrier(0);
#pragma unroll
    for (int eb = 0; eb < 2; ++eb) { aF[eb] = f32x16{}; aB[eb] = f32x16{};
#pragma unroll
        for (int d0 = 0; d0 < 4; ++d0) {
            const bf16x8 rf = cat8(vtr(prf + d0 * 2048 + 64 * eb), vtr(prf + d0 * 2048 + 512 + 64 * eb));
            const bf16x8 rb = cat8(vtr(prb + d0 * 2048 + 64 * eb), vtr(prb + d0 * 2048 + 512 + 64 * eb));
            aF[eb] = MFMA32(qf[d0], rf, aF[eb]); aB[eb] = MFMA32(qf[d0], rb, aB[eb]); } }
    __builtin_amdgcn_sched_barrier(0);
    const float* rng = A.in[5] + l * 64; const float g0 = rng[r32], g1 = rng[32 + r32];
#pragma unroll
    for (int r = 0; r < 16; ++r) {
        const int tl = t0 + crow(r, hi);
        const float wf = __builtin_amdgcn_exp2f(lgf2 * (float)(tl + 1)), wb = __builtin_amdgcn_exp2f(lgb2 * (float)(CH - tl));
        const float v0 = aI[0][r] + wf * aF[0][r] + wb * aB[0][r], v1 = aI[1][r] + wf * aF[1][r] + wb * aB[1][r];
        const float ss = half_sum32(v0 * v0 + v1 * v1); const float rs = __builtin_amdgcn_rsqf(ss * (1.0f / 64.0f) + EPS);
        const LAS unsigned short* grow = (const LAS unsigned short*)(GW + crow(r, hi) * 128) + r32;
        const float ga = bf2f(grow[0]), gb = bf2f(grow[32]);
        const float sa = ga * __builtin_amdgcn_rcpf(1.0f + __builtin_amdgcn_exp2f(-LOG2E * ga)), sb2 = gb * __builtin_amdgcn_rcpf(1.0f + __builtin_amdgcn_exp2f(-LOG2E * gb));
        LAS unsigned short* orow = (LAS unsigned short*)(GW + crow(r, hi) * 128) + r32;
        orow[0] = (unsigned short)(pk2(v0 * rs * g0 * sa, 0.f) & 0xffffu); orow[32] = (unsigned short)(pk2(v1 * rs * g1 * sb2, 0.f) & 0xffffu);
    }
    asm volatile("s_waitcnt lgkmcnt(0)" ::: "memory");
#pragma unroll
    for (int i = 0; i < 4; ++i) { const int pc = lane + 64 * i, rw = pc >> 3, ch = pc & 7;
        *(u32x4*)(MIX + (row0 + t0 + rw) * DM + h * 64 + 8 * ch) = *(const LAS u32x4*)(GW + rw * 128 + ch * 16); }
    __syncthreads();
}

#define XB_TMO      128
#define XB_XCNT(j)  (256  + 64 * (j))
#define XB_XSUB(j)  (1280 + 64 * (j))
#define XB_XGEN(j)  (2304 + 64 * (j))
#define XB_TOP      3328
#define XB_TOPGEN   3392
#define XCD_BAR_WORDS 3456
#define XB_SPIN_CAP (1u << 18)

__device__ __forceinline__ unsigned xb_ld(unsigned* p)              { return __hip_atomic_load(p, __ATOMIC_RELAXED, __HIP_MEMORY_SCOPE_AGENT); }
__device__ __forceinline__ unsigned xb_add(unsigned* p, unsigned v) { return __hip_atomic_fetch_add(p, v, __ATOMIC_RELAXED, __HIP_MEMORY_SCOPE_AGENT); }
__device__ __forceinline__ unsigned xb_xcc_id() { return (unsigned)__builtin_amdgcn_s_getreg((3 << 11) | 20) & 0xFu; }
#define XB_SPIN(cond, bar) do { unsigned _sp = 0; while (cond) { __builtin_amdgcn_s_sleep(1); \
    if ((++_sp & 255u) == 0u) { if (xb_ld(&(bar)[XB_TMO])) break; if (_sp > XB_SPIN_CAP) { atomicAdd(&(bar)[XB_TMO], 1u); break; } } } } while (0)

struct XcdBarrier {
    unsigned* bar; unsigned x;
    volatile LAS unsigned* st;
};

__device__ __forceinline__ XcdBarrier xcd_barrier_post(unsigned* bar, volatile LAS unsigned* st) {
    XcdBarrier b; b.bar = bar; b.x = xb_xcc_id(); b.st = st;
    if (threadIdx.x == 0) (void)xb_add(&bar[XB_XCNT(b.x)], 1u);
    return b;
}
__device__ __forceinline__ void xcd_barrier_complete(unsigned* bar, unsigned x, unsigned& nloc, unsigned& nx) {
    const unsigned G = gridDim.x * gridDim.y * gridDim.z;
    unsigned sum, cnt, mine, sp = 0u;
    for (;;) {
        sum = 0u; cnt = 0u; mine = 0u;
#pragma unroll
        for (unsigned j = 0; j < 16; ++j) { const unsigned c = xb_ld(&bar[XB_XCNT(j)]); sum += c; cnt += (c > 0u) ? 1u : 0u; mine = (j == x) ? c : mine; }
        if (sum == G) break;
        __builtin_amdgcn_s_sleep(1);
        if ((++sp & 255u) == 0u) { if (xb_ld(&bar[XB_TMO])) break; if (sp > XB_SPIN_CAP) { atomicAdd(&bar[XB_TMO], 1u); break; } }
    }
    nloc = mine > 0u ? mine : 1u; nx = cnt > 0u ? cnt : 1u;
}

__device__ __forceinline__ void xcd_barrier(const XcdBarrier& b) {
    asm volatile("s_waitcnt vmcnt(0)" ::: "memory");
    __syncthreads();
    if (threadIdx.x == 0) {
        unsigned* bar = b.bar;
        __builtin_amdgcn_s_waitcnt(0);
        unsigned nloc = b.st[0], nx = b.st[1];
        if (nloc == 0u) { xcd_barrier_complete(bar, b.x, nloc, nx); b.st[0] = nloc; b.st[1] = nx; }
        const unsigned old = xb_add(&bar[XB_XSUB(b.x)], 1u);
        const unsigned gen = old / nloc;
        if (old + 1u == (gen + 1u) * nloc) {
            __builtin_amdgcn_fence(__ATOMIC_RELEASE, "agent");
            asm volatile("s_waitcnt vmcnt(0)" ::: "memory");
            const unsigned og = xb_add(&bar[XB_TOP], 1u);
            const unsigned tg = og / nx;
            if (og + 1u == (tg + 1u) * nx) xb_add(&bar[XB_TOPGEN], 1u);
            else XB_SPIN(xb_ld(&bar[XB_TOPGEN]) == tg, bar);
            __builtin_amdgcn_fence(__ATOMIC_ACQUIRE, "agent");
            xb_add(&bar[XB_XGEN(b.x)], 1u);
            asm volatile("s_waitcnt vmcnt(0)" ::: "memory");
        } else {
            XB_SPIN(xb_ld(&bar[XB_XGEN(b.x)]) == gen, bar);
            __builtin_amdgcn_fence(__ATOMIC_ACQUIRE, "agent");
            asm volatile("s_waitcnt vmcnt(0)" ::: "memory");
        }
    }
    __syncthreads();
}

constexpr int N_PHASES = 1 + 7 * DEPTH;

__global__ void __launch_bounds__(NWAVES * 64, 2) fwd_megakernel(Args args) {
    extern __shared__ __attribute__((aligned(1024))) unsigned char lds_raw[];
    cg::grid_group grid = cg::this_grid();
    Frame F0;
    F0.lds = (LAS unsigned char*)lds_raw;
    F0.tid = threadIdx.x; F0.lane = F0.tid & 63; F0.wave = __builtin_amdgcn_readfirstlane(F0.tid >> 6);
    F0.G = gridDim.x; { const int bx0 = blockIdx.x; F0.vcu = (F0.G % 8 == 0) ? (bx0 % 8) * (F0.G / 8) + bx0 / 8 : bx0; }
    F0.out = args.out; F0.ws = args.ws;
    const int lo = args.ph_lo, hi = args.ph_hi;
    for (int u = threadIdx.x; u < 64; u += NWAVES * 64) ((LAS unsigned*)(F0.lds + LDS_MISC))[u] = 0u;
    __syncthreads();
    (void)xcd_barrier_post((unsigned*)(args.ws + WS_CTL + BAR_OFF), (volatile LAS unsigned*)(F0.lds + LDS_MISC) + 8);
#define IN(k) (lo <= (k) && (k) < hi)
    if (lo < 0) grid.sync();
#define xcd_seam() do { if (IN(pb + 3)) { unsigned char* w_ = args.ws; asm volatile("" : "+s"(w_)); XcdBarrier b_; b_.bar = (unsigned*)(w_ + WS_CTL + BAR_OFF); b_.x = xb_xcc_id(); b_.st = (volatile LAS unsigned*)(F0.lds + LDS_MISC) + 8; xcd_barrier(b_); } } while (0)
#define SEAM(k) do { if (IN(k) && IN((k) + 1)) { unsigned char* w_ = args.ws; asm volatile("" : "+s"(w_)); XcdBarrier b_; b_.bar = (unsigned*)(w_ + WS_CTL + BAR_OFF); b_.x = xb_xcc_id(); b_.st = (volatile LAS unsigned*)(F0.lds + LDS_MISC) + 8; xcd_barrier(b_); } } while (0)
#define PH_BEGIN() Frame F = F0; int bx = (int)blockIdx.x; asm volatile("" : "+s"(F.ws), "+s"(F.out), "+s"(F.G), "+s"(F.vcu), "+s"(bx), "+s"(F.wave), "+v"(F.lane)); F.tid = (F.wave << 6) | F.lane; \
    float* SSQ = (float*)(F.ws + WS_CTL); bf16* XB = (bf16*)(F.ws + WS_XB); bf16* PROJ = (bf16*)(F.ws + WS_PROJ); bf16* MIX = (bf16*)(F.ws + WS_MIX); bf16* HID = (bf16*)(F.ws + WS_HID); \
    (void)SSQ; (void)XB; (void)PROJ; (void)MIX; (void)HID; (void)bx;
#ifndef SKIP_P0
    if (IN(0)) { PH_BEGIN(); p0_prologue(F, args); }
#endif
    SEAM(0);
#pragma unroll
    for (int l = 0; l < DEPTH; ++l) {
        const int pb = 1 + 7 * l;
#ifndef SKIP_G1
        if (IN(pb)) {
            PH_BEGIN();
            pg8::Gemm g{XB, (const bf16*)(F.ws + WS_WIN) + (size_t)l * NPROJ * DM, M, NPROJ, DM}; pg8::StaticOrder S; S.init(M, NPROJ, F.G, bx);
            pg8::EpiProj E{PROJ, NPROJ, SSQ + (size_t)(2 * l) * M};
            pg8::gemm_phase<pg8::EpiProj, pg8::StaticOrder, true, true>(F.lds, g, S, E, F.tid);
        }
#endif
        SEAM(pb);
        if (IN(pb + 1)) {
            PH_BEGIN();
#ifndef SKIP_RKV
            for (int it = F.vcu; it < BATCH * RH * NCH; it += F.G) ret_kv_item(F, args, l, it);
#endif
            qknorm_pass(F, args, l);
        } SEAM(pb + 1);
        if (IN(pb + 2)) { PH_BEGIN(); ret_scan(F, args, l); } SEAM(pb + 2);
        if (IN(pb + 3)) {
            PH_BEGIN();
#pragma unroll 1
            for (int it = F.vcu; it < 512; it += F.G) {
                const int k = it >> 8, v = it & 255, x = v >> 5, j = v & 31, bb = (x >> 1) & 1, mm = x >> 2;
                const int hh = k == 0 ? 3 - (x & 1) : ((x & 1) ? 1 : 0), qq = (k == 1 && (x & 1)) ? ((j + 16) & 31) : j;
                attn_half(F, args, l, bb, hh, qq, mm);
            }
            {
                const bool g256 = (F.G == 256); const bool take = g256 ? !((F.vcu >> 5) & 1) : true;
                const int rs = g256 ? ((F.vcu >> 6) * 32 + (F.vcu & 31)) : F.vcu, rstride = g256 ? 128 : F.G;
                if (take) {
#pragma unroll 1
                    for (int pr = rs; pr < BATCH * RH * NCH / 2; pr += rstride) ret_out_pair(F, args, l, pr);
                }
            }
        } xcd_seam();
        if (IN(pb + 3)) { PH_BEGIN(); attn_combine(F, args, l); }
        SEAM(pb + 3);
#ifndef SKIP_G2
        if (IN(pb + 4)) {
            PH_BEGIN();
            pg8::Gemm g{MIX, (const bf16*)(F.ws + WS_WOUT) + (size_t)l * DM * DM, M, DM, DM}; pg8::StaticOrder S; S.init(M, DM, F.G, bx);
            pg8::EpiRes E{XB, nullptr, SSQ + (size_t)(2 * l + 1) * M};
            pg8::gemm_phase<pg8::EpiRes, pg8::StaticOrder, true, true>(F.lds, g, S, E, F.tid);
        }
#endif
        SEAM(pb + 4);
#ifndef SKIP_G3
        if (IN(pb + 5)) {
            PH_BEGIN();
            pg8::Gemm g{XB, (const bf16*)(F.ws + WS_WGU) + (size_t)l * NGU * DM, M, NGU, DM}; pg8::StaticOrder S; S.init(M, NGU, F.G, bx);
            pg8::EpiSwiglu E{HID, FF, SSQ + (size_t)(2 * l + 1) * M};
            pg8::gemm_phase<pg8::EpiSwiglu, pg8::StaticOrder, true, true>(F.lds, g, S, E, F.tid);
        }
#endif
        SEAM(pb + 5);
#ifndef SKIP_G4
        if (IN(pb + 6)) {
            PH_BEGIN();
            pg8::Gemm g{HID, (const bf16*)(F.ws + WS_WDN) + (size_t)l * DM * FF, M, DM, FF}; pg8::StaticOrder S; S.init(M, DM, F.G, bx);
            const bool last = (l == DEPTH - 1);
            pg8::EpiRes E{XB, last ? F.out : nullptr, SSQ + (size_t)(2 * l + 2 < 4 ? 2 * l + 2 : 0) * M};
            pg8::gemm_phase<pg8::EpiRes, pg8::StaticOrder, true, true>(F.lds, g, S, E, F.tid);
        }
#endif
        SEAM(pb + 6);
    }
#undef IN
#undef SEAM
}

#ifndef MK_N_LAUNCHES
#define MK_N_LAUNCHES 1
#endif
extern "C" void kernel_launch(void* const* d_in, const int* in_sizes, int n_in, void* d_out, int out_size, void* d_ws, size_t ws_size, hipStream_t stream) {
    static int grid = 0;
    if (grid == 0) {
        if (n_in != 18 || out_size != M * DM || ws_size < WS_END) { fprintf(stderr, "kernel_launch: unexpected shapes (n_in %d out %d ws %zu)\n", n_in, out_size, ws_size); grid = -1; return; }
        int dev = 0, cus = 0, per_cu = 0;
        hipGetDevice(&dev); hipDeviceGetAttribute(&cus, hipDeviceAttributeMultiprocessorCount, dev);
        if (hipFuncSetAttribute((const void*)fwd_megakernel, hipFuncAttributeMaxDynamicSharedMemorySize, LDS_BYTES) != hipSuccess) { fprintf(stderr, "kernel_launch: hipFuncSetAttribute failed\n"); grid = -1; return; }
        if (hipOccupancyMaxActiveBlocksPerMultiprocessor(&per_cu, (const void*)fwd_megakernel, NWAVES * 64, LDS_BYTES) != hipSuccess || per_cu < 1) { fprintf(stderr, "kernel_launch: occupancy query failed (%d)\n", per_cu); (void)hipGetLastError(); per_cu = 1; }
        grid = cus * per_cu;
    }
    if (grid < 0) return;
    hipMemsetAsync((char*)d_ws + WS_CTL, 0, CTL_BYTES, stream);
    Args a{};
    for (int i = 0; i < 18; ++i) a.in[i] = (const float*)d_in[i];
    a.out = (float*)d_out; a.ws = (unsigned char*)d_ws;
    const int nl = MK_N_LAUNCHES;
    for (int li = 0; li < nl; ++li) {
        a.ph_lo = (nl == 1) ? 0 : li; a.ph_hi = (nl == 1) ? N_PHASES : li + 1;
        void* kargs[] = {&a};
        hipError_t e = hipLaunchCooperativeKernel((const void*)fwd_megakernel, dim3(grid), dim3(NWAVES * 64), kargs, LDS_BYTES, stream);
        if (e != hipSuccess) { fprintf(stderr, "kernel_launch: cooperative launch %d failed: %s (grid %d)\n", li, hipGetErrorString(e), grid); break; }
    }
}
```

```cpp
#include <hip/hip_runtime.h>
#include <hip/hip_cooperative_groups.h>
#include <cstdio>
#include <cstdint>
namespace cg = cooperative_groups;
namespace pg8 {
#define PG8_LAS __attribute__((address_space(3)))
typedef unsigned short bf16_t;
typedef short bf16x8 __attribute__((ext_vector_type(8)));
typedef float f32x4 __attribute__((ext_vector_type(4)));
typedef unsigned u32x4 __attribute__((ext_vector_type(4)));
constexpr int BM = 256, BK = 64, HALF = 128, HTB = HALF * BK * 2  , STAGE_BYTES = 8 * HTB, NXCD = 8;

__host__ __device__ __forceinline__ int lds_byte(int r, int c) { const int st = (r >> 4) * 2 + (c >> 5), rr = r & 15, cc = c & 31, ob = rr * 64 + cc * 2; return st * 1024 + (ob ^ (((ob >> 9) & 1) << 5)); }
__host__ __device__ __forceinline__ void stage_rc(int b, int& R, int& C) { const int st = b / 1024, sb = b % 1024, swz = sb ^ (((sb >> 9) & 1) << 5); R = (st >> 1) * 16 + swz / 64; C = (st & 1) * 32 + (swz % 64) / 2; }
__host__ __device__ __forceinline__ int perm32(int rho) { const int n = rho >> 4, i = rho & 15; return 8 * (i >> 2) + 4 * n + (i & 3); }

struct Unit { int pm, pn; };
struct Gemm { const bf16_t* A; const bf16_t* Bt; int M, N, K; };

struct StaticOrder {
    int nM, nN, nwg, G, c, WGM;
    __host__ __device__ void init(int M, int N, int G_, int c_, int wgm_) { nM = M / BM; nN = N / BM; nwg = nM * nN; G = G_; c = c_; WGM = wgm_; }
    __host__ __device__ bool next(int i, Unit& u) const {
        const long L = (long)i * G + c; if (L >= nwg) return false;
        int wgid = (int)L; { const int q = nwg / NXCD, r = nwg % NXCD, xcd = wgid % NXCD, off = wgid / NXCD; wgid = (xcd < r ? xcd * (q + 1) : r * (q + 1) + (xcd - r) * q) + off; }
        const int nig = WGM * nN, gid = wgid / nig, fm = gid * WGM, gsz = (nM - fm) < WGM ? (nM - fm) : WGM;
        u.pm = fm + ((wgid % nig) % gsz); u.pn = (wgid % nig) / gsz; return true;
    }
    __device__ __forceinline__ void a_ready(const Unit&) const {}
    __device__ __forceinline__ void done(const Unit&) const {}
};

__device__ __forceinline__ unsigned cvt_pk_bf16(float lo, float hi) { unsigned r; asm volatile("v_cvt_pk_bf16_f32 %0, %1, %2" : "=v"(r) : "v"(lo), "v"(hi)); return r; }
typedef float f32x2 __attribute__((ext_vector_type(2)));
typedef unsigned u32x2 __attribute__((ext_vector_type(2)));
constexpr float RMS_EPS = 1e-6f;
struct EpiProj {
    static constexpr bool PERM = true, AFTER_DRAIN = false;
    bf16_t* O; int ldc; const float* ssq;
    __device__ __forceinline__ void operator()(const f32x4 (&acc)[2][2][4][2], const Unit& u, int wr, int wc, int fr, int fq) const {
        const int row0 = u.pm * BM + wr * 64 + fr, col0 = u.pn * BM + wc * 32 + 8 * fq;
#pragma unroll
        for (int ai = 0; ai < 2; ++ai)
#pragma unroll
            for (int m = 0; m < 4; ++m) { const int row = row0 + ai * HALF + m * 16; const float rs = __builtin_amdgcn_rsqf(ssq[row] * (1.0f / 1024.0f) + RMS_EPS);
                bf16_t* rowp = O + (size_t)row * ldc + col0;
#pragma unroll
                for (int bj = 0; bj < 2; ++bj) { const f32x4 v0 = acc[ai][bj][m][0] * rs, v1 = acc[ai][bj][m][1] * rs;
                    u32x4 w; w.x = cvt_pk_bf16(v0[0], v0[1]); w.y = cvt_pk_bf16(v0[2], v0[3]); w.z = cvt_pk_bf16(v1[0], v1[1]); w.w = cvt_pk_bf16(v1[2], v1[3]);
                    *(u32x4*)(rowp + bj * HALF) = w; } }
    }
};
struct EpiSwiglu {
    static constexpr bool PERM = true, AFTER_DRAIN = false;
    bf16_t* O; int ldc; const float* ssq;
    __device__ __forceinline__ void operator()(const f32x4 (&acc)[2][2][4][2], const Unit& u, int wr, int wc, int fr, int fq) const {
        const int row0 = u.pm * BM + wr * 64 + fr, col0 = u.pn * HALF + wc * 32 + 8 * fq;
#pragma unroll
        for (int ai = 0; ai < 2; ++ai)
#pragma unroll
            for (int m = 0; m < 4; ++m) { const int row = row0 + ai * HALF + m * 16; const float rs = __builtin_amdgcn_rsqf(ssq[row] * (1.0f / 1024.0f) + RMS_EPS);
                float hv[8];
#pragma unroll
                for (int n = 0; n < 2; ++n)
#pragma unroll
                    for (int j = 0; j < 4; ++j) { const float g = acc[ai][0][m][n][j] * rs, up = acc[ai][1][m][n][j] * rs;
                        const float sg = g * __builtin_amdgcn_rcpf(1.0f + __builtin_amdgcn_exp2f(-1.4426950408889634f * g)); hv[n * 4 + j] = sg * up; }
                u32x4 w; w.x = cvt_pk_bf16(hv[0], hv[1]); w.y = cvt_pk_bf16(hv[2], hv[3]); w.z = cvt_pk_bf16(hv[4], hv[5]); w.w = cvt_pk_bf16(hv[6], hv[7]);
                *(u32x4*)(O + (size_t)row * ldc + col0) = w; }
    }
};
struct EpiRes {
    static constexpr bool PERM = true, AFTER_DRAIN = false;
    bf16_t* xb; float* out; float* ssq;
    __device__ __forceinline__ void operator()(const f32x4 (&acc)[2][2][4][2], const Unit& u, int wr, int wc, int fr, int fq) const {
        const int row0 = u.pm * BM + wr * 64 + fr, col0 = u.pn * BM + wc * 32 + 8 * fq;
#pragma unroll
        for (int ai = 0; ai < 2; ++ai)
#pragma unroll
            for (int m = 0; m < 4; ++m) { const int row = row0 + ai * HALF + m * 16; const size_t off = (size_t)row * 1024 + col0; float part = 0.f;
#pragma unroll
                for (int bj = 0; bj < 2; ++bj) { const size_t o = off + bj * HALF; const u32x4 rb = *(const u32x4*)(xb + o);
                    f32x4 v0, v1;
                    v0[0] = __uint_as_float(rb.x << 16) + acc[ai][bj][m][0][0]; v0[1] = __uint_as_float(rb.x & 0xffff0000u) + acc[ai][bj][m][0][1];
                    v0[2] = __uint_as_float(rb.y << 16) + acc[ai][bj][m][0][2]; v0[3] = __uint_as_float(rb.y & 0xffff0000u) + acc[ai][bj][m][0][3];
                    v1[0] = __uint_as_float(rb.z << 16) + acc[ai][bj][m][1][0]; v1[1] = __uint_as_float(rb.z & 0xffff0000u) + acc[ai][bj][m][1][1];
                    v1[2] = __uint_as_float(rb.w << 16) + acc[ai][bj][m][1][2]; v1[3] = __uint_as_float(rb.w & 0xffff0000u) + acc[ai][bj][m][1][3];
                    if (out) { *(f32x4*)(out + o) = v0; *(f32x4*)(out + o + 4) = v1; }
                    else { part += ((v0[0] * v0[0] + v0[1] * v0[1]) + (v0[2] * v0[2] + v0[3] * v0[3])) + ((v1[0] * v1[0] + v1[1] * v1[1]) + (v1[2] * v1[2] + v1[3] * v1[3]));
                        u32x4 w; w.x = cvt_pk_bf16(v0[0], v0[1]); w.y = cvt_pk_bf16(v0[2], v0[3]); w.z = cvt_pk_bf16(v1[0], v1[1]); w.w = cvt_pk_bf16(v1[2], v1[3]); *(u32x4*)(xb + o) = w; } }
                if (!out) { part += __shfl_xor(part, 16); part += __shfl_xor(part, 32);
                    if (fq == 0) __hip_atomic_fetch_add(ssq + row, part, __ATOMIC_RELAXED, __HIP_MEMORY_SCOPE_AGENT); } }
    }
};
template <class Epi, class Sched, bool ALIGN_EPI = false, bool SP2 = false>
__device__ __forceinline__ void gemm_phase(PG8_LAS unsigned char* lds, const Gemm g, const Sched& S, const Epi& E, const int tid_in) {
    const int tid = tid_in, wid = __builtin_amdgcn_readfirstlane(tid >> 6), lane = tid & 63, wr = wid >> 2, wc = wid & 3, fr = lane & 15, fq = lane >> 4;
    const int K = g.K, nt = K / BK;
    unsigned voffA[2], voffB[2];
#pragma unroll
    for (int i = 0; i < 2; ++i) { int R, C; stage_rc(tid * 16 + i * 8192, R, C); const int Rb = Epi::PERM ? ((R & ~31) + perm32(R & 31)) : R;
        voffA[i] = (unsigned)(R * K + C) * 2u; voffB[i] = (unsigned)(Rb * K + C) * 2u; }
    const size_t kstep = (size_t)(BK * 2);
    const size_t hstep = (size_t)HALF * K * 2;
    const size_t tstep = 2 * hstep;
    const unsigned ldsw = (unsigned)wid * 1024u;
    const int aoff = lds_byte(wr * 64 + fr, fq * 8), boff = lds_byte(wc * 32 + fr, fq * 8);
#define PG8_SA(b, h) (((b) * 2 + (h)) * HTB)
#define PG8_SB(b, h) ((4 + (b) * 2 + (h)) * HTB)
#define PG8_STAGE(bufoff, gbase, voff) do { _Pragma("unroll") for (int _i = 0; _i < 2; ++_i) \
        __builtin_amdgcn_global_load_lds((const unsigned*)((const char*)(gbase) + (voff)[_i]), (PG8_LAS unsigned*)(lds + (bufoff) + ldsw + _i * 8192), 16, 0, 0); } while (0)
#define PG8_LDA(dst, b, h) do { _Pragma("unroll") for (int m = 0; m < 4; ++m) _Pragma("unroll") for (int k = 0; k < 2; ++k) dst[m][k] = *(const PG8_LAS bf16x8*)(lds + PG8_SA(b, h) + aoff + m * 2048 + k * 1024); } while (0)
#define PG8_LDB(dst, b, h) do { _Pragma("unroll") for (int n = 0; n < 2; ++n) _Pragma("unroll") for (int k = 0; k < 2; ++k) dst[n][k] = *(const PG8_LAS bf16x8*)(lds + PG8_SB(b, h) + boff + n * 2048 + k * 1024); } while (0)
#define PG8_MMA(ai, bj, At, Bt) do { __builtin_amdgcn_s_setprio(1); _Pragma("unroll") for (int m = 0; m < 4; ++m) _Pragma("unroll") for (int n = 0; n < 2; ++n) _Pragma("unroll") for (int k = 0; k < 2; ++k) \
        acc[ai][bj][m][n] = __builtin_amdgcn_mfma_f32_16x16x32_bf16(Bt[n][k], At[m][k], acc[ai][bj][m][n], 0, 0, 0); __builtin_amdgcn_s_setprio(0); } while (0)
#define PG8_WAIT_V(n) asm volatile("s_waitcnt vmcnt(" #n ")" ::: "memory")
#define PG8_WAIT_L(n) asm volatile("s_waitcnt lgkmcnt(" #n ")" ::: "memory")
#define PG8_BAR __builtin_amdgcn_s_barrier()
#define PG8_SCHED __builtin_amdgcn_sched_barrier(0)
    Unit cur, nxt; int ui = 0;
    if (!S.next(0, cur)) return;
    f32x4 acc[2][2][4][2];
#pragma unroll
    for (int a = 0; a < 2; ++a)
#pragma unroll
        for (int b = 0; b < 2; ++b)
#pragma unroll
            for (int m = 0; m < 4; ++m)
#pragma unroll
                for (int n = 0; n < 2; ++n) acc[a][b][m][n] = (f32x4){0.f, 0.f, 0.f, 0.f};
    bf16x8 At[4][2], B0[2][2], B1[2][2];
    const char* cA = (const char*)g.A + (size_t)cur.pm * tstep; const char* cB = (const char*)g.Bt + (size_t)cur.pn * tstep;
    S.a_ready(cur);
    if constexpr (SP2) {
        PG8_STAGE(PG8_SB(0, 0), cB, voffB); PG8_STAGE(PG8_SB(0, 1), cB + hstep, voffB); PG8_STAGE(PG8_SA(0, 0), cA, voffA); PG8_STAGE(PG8_SA(0, 1), cA + hstep, voffA);
        if (wr == 1) PG8_BAR;
        PG8_WAIT_V(2); PG8_BAR;
        PG8_STAGE(PG8_SB(1, 0), cB + kstep, voffB); PG8_STAGE(PG8_SA(1, 0), cA + kstep, voffA); PG8_STAGE(PG8_SB(1, 1), cB + hstep + kstep, voffB);
        PG8_WAIT_V(6); PG8_BAR;
    } else {
        PG8_STAGE(PG8_SB(0, 0), cB, voffB); PG8_STAGE(PG8_SA(0, 0), cA, voffA); PG8_STAGE(PG8_SB(0, 1), cB + hstep, voffB); PG8_STAGE(PG8_SA(0, 1), cA + hstep, voffA);
        if (wr == 1) PG8_BAR;
        PG8_WAIT_V(4); PG8_BAR;
        PG8_STAGE(PG8_SB(1, 0), cB + kstep, voffB); PG8_STAGE(PG8_SA(1, 0), cA + kstep, voffA); PG8_STAGE(PG8_SB(1, 1), cB + hstep + kstep, voffB);
        PG8_WAIT_V(6); PG8_BAR;
    }
    for (;;) {
        const bool has_next = S.next(ui + 1, nxt);
        const char* nA = has_next ? (const char*)g.A + (size_t)nxt.pm * tstep : cA; const char* nB = has_next ? (const char*)g.Bt + (size_t)nxt.pn * tstep : cB;
        for (int t = 0; t < nt; t += 2) {
            const bool last = (t == nt - 2);
            const char* a1 = cA + (size_t)(t + 1) * kstep;
            const char* a2 = last ? nA : cA + (size_t)(t + 2) * kstep; const char* b2 = last ? nB : cB + (size_t)(t + 2) * kstep;
            const char* a3 = a2 + kstep; const char* b3 = b2 + kstep;
            if (last && has_next) S.a_ready(nxt);
            if constexpr (SP2) {
            PG8_LDB(B0, 0, 0); PG8_LDB(B1, 0, 1); PG8_SCHED; PG8_LDA(At, 0, 0); PG8_STAGE(PG8_SA(1, 1), a1 + hstep, voffA);
            PG8_WAIT_V(8); PG8_WAIT_L(0); PG8_BAR; PG8_MMA(0, 0, At, B0); PG8_MMA(0, 1, At, B1); PG8_BAR; PG8_SCHED;
            PG8_LDA(At, 0, 1); PG8_STAGE(PG8_SB(0, 0), b2, voffB); PG8_STAGE(PG8_SB(0, 1), b2 + hstep, voffB); PG8_STAGE(PG8_SA(0, 0), a2, voffA);
            PG8_WAIT_V(8); PG8_WAIT_L(0); PG8_BAR; PG8_MMA(1, 0, At, B0); PG8_MMA(1, 1, At, B1); PG8_BAR; PG8_SCHED;
            PG8_LDB(B0, 1, 0); PG8_LDB(B1, 1, 1); PG8_SCHED; PG8_LDA(At, 1, 0); PG8_STAGE(PG8_SA(0, 1), a2 + hstep, voffA);
            PG8_WAIT_V(8); PG8_WAIT_L(0); PG8_BAR; PG8_MMA(0, 0, At, B0); PG8_MMA(0, 1, At, B1); PG8_BAR; PG8_SCHED;
            PG8_LDA(At, 1, 1); PG8_STAGE(PG8_SB(1, 0), b3, voffB); PG8_STAGE(PG8_SB(1, 1), b3 + hstep, voffB); PG8_STAGE(PG8_SA(1, 0), a3, voffA);
            PG8_WAIT_V(8); PG8_WAIT_L(0); PG8_BAR; PG8_MMA(1, 0, At, B0); PG8_MMA(1, 1, At, B1); PG8_BAR; PG8_SCHED;
            } else {
            PG8_LDB(B0, 0, 0); PG8_SCHED; PG8_LDA(At, 0, 0); PG8_STAGE(PG8_SA(1, 1), a1 + hstep, voffA);
            PG8_WAIT_L(8); PG8_BAR; PG8_WAIT_L(0); PG8_MMA(0, 0, At, B0); PG8_BAR; PG8_SCHED;
            PG8_LDB(B1, 0, 1); PG8_STAGE(PG8_SB(0, 0), b2, voffB);
            PG8_BAR; PG8_WAIT_L(0); PG8_MMA(0, 1, At, B1); PG8_BAR;
            PG8_LDA(At, 0, 1); PG8_STAGE(PG8_SA(0, 0), a2, voffA);
            PG8_BAR; PG8_WAIT_L(0); PG8_MMA(1, 0, At, B0); PG8_BAR; PG8_SCHED;
            PG8_STAGE(PG8_SB(0, 1), b2 + hstep, voffB);
            PG8_WAIT_V(6); PG8_BAR; PG8_MMA(1, 1, At, B1); PG8_BAR;
            PG8_LDB(B0, 1, 0); PG8_SCHED; PG8_LDA(At, 1, 0); PG8_STAGE(PG8_SA(0, 1), a2 + hstep, voffA);
            PG8_WAIT_L(8); PG8_BAR; PG8_WAIT_L(0); PG8_MMA(0, 0, At, B0); PG8_BAR; PG8_SCHED;
            PG8_LDB(B1, 1, 1); PG8_STAGE(PG8_SB(1, 0), b3, voffB);
            PG8_BAR; PG8_WAIT_L(0); PG8_MMA(0, 1, At, B1); PG8_BAR;
            PG8_LDA(At, 1, 1); PG8_STAGE(PG8_SA(1, 0), a3, voffA);
            PG8_BAR; PG8_WAIT_L(0); PG8_MMA(1, 0, At, B0); PG8_BAR; PG8_SCHED;
            PG8_STAGE(PG8_SB(1, 1), b3 + hstep, voffB);
            PG8_WAIT_V(6); PG8_BAR; PG8_MMA(1, 1, At, B1); PG8_BAR;
            }
        }
        if constexpr (ALIGN_EPI) { if (wr == 0) PG8_BAR; }
        if constexpr (!Epi::AFTER_DRAIN) { E(acc, cur, wr, wc, fr, fq); S.done(cur); }
        if (!has_next) break;
#pragma unroll
        for (int a = 0; a < 2; ++a)
#pragma unroll
            for (int b = 0; b < 2; ++b)
#pragma unroll
                for (int m = 0; m < 4; ++m)
#pragma unroll
                    for (int n = 0; n < 2; ++n) acc[a][b][m][n] = (f32x4){0.f, 0.f, 0.f, 0.f};
        cur = nxt; cA = nA; cB = nB; ++ui;
        if constexpr (ALIGN_EPI) { if (wr == 1) PG8_BAR; }
    }
    PG8_WAIT_V(0);
    if constexpr (!ALIGN_EPI) { if (wr == 0) PG8_BAR; }
    PG8_BAR;
    if constexpr (Epi::AFTER_DRAIN) { E.fused(acc, cur, wr, wc, fr, fq, lds, wid, lane); S.done(cur); }
#undef PG8_SA
#undef PG8_SB
#undef PG8_STAGE
#undef PG8_LDA
#undef PG8_LDB
#undef PG8_MMA
#undef PG8_WAIT_V
#undef PG8_WAIT_L
#undef PG8_BAR
#undef PG8_SCHED
}
}

constexpr int BATCH = 2, SEQ = 8192, DM = 1024, DEPTH = 2;
constexpr int M = BATCH * SEQ;
constexpr int NPROJ = 3584, FF = 2816, NGU = 2 * FF;
constexpr int RH = 8, CH = 128, NCH = SEQ / CH;
constexpr int C_RQ = 0, C_RK = 512, C_RV = 1024, C_RG = 1536, C_DQ = 2048, C_DK = 2560, C_DV = 3072;
constexpr float EPS = 1e-6f, LOG2E = 1.4426950408889634f;
constexpr size_t MiB = 1u << 20;
constexpr size_t WS_CTL = 0, CTL_BYTES = 1 * MiB;
constexpr size_t WS_WIN = 1 * MiB, WS_WOUT = 15 * MiB, WS_WGU = 19 * MiB, WS_WDN = 41 * MiB;
constexpr size_t WS_XB = 52 * MiB;
constexpr size_t WS_MIX = 84 * MiB, WS_PROJ = 116 * MiB, WS_HID = 116 * MiB, WS_RF = 228 * MiB, WS_RB = 236 * MiB, WS_END = 244 * MiB;
constexpr size_t PAR_OFF = 512 * 1024, BAR_OFF = 768 * 1024;
constexpr int LDS_MISC = 131072;
constexpr int LDS_BYTES = 135168;
constexpr int NWAVES = 8;
#ifndef WGM_IN
#define WGM_IN 4
#endif
#ifndef WGM_GU
#define WGM_GU 4
#endif
#ifndef WGM_SQ
#define WGM_SQ 8
#endif

#define LAS __attribute__((address_space(3)))
typedef unsigned short bf16;
typedef short bf16x8 __attribute__((ext_vector_type(8)));
typedef short s16x4 __attribute__((ext_vector_type(4)));
typedef short v4i16_t __attribute__((ext_vector_type(4)));
typedef float f32x4 __attribute__((ext_vector_type(4)));
typedef float f32x16 __attribute__((ext_vector_type(16)));
typedef unsigned u32x4 __attribute__((ext_vector_type(4)));
typedef float f32x2_t __attribute__((ext_vector_type(2)));
typedef __bf16 bf16x2_t __attribute__((ext_vector_type(2)));

__device__ __forceinline__ unsigned pk2(float lo, float hi) { f32x2_t v = {lo, hi}; bf16x2_t b = __builtin_convertvector(v, bf16x2_t); return __builtin_bit_cast(unsigned, b); }
__device__ __forceinline__ float bf2f(unsigned short b) { return __uint_as_float((unsigned)b << 16); }
__device__ __forceinline__ float bflo(unsigned w) { return __uint_as_float(w << 16); }
__device__ __forceinline__ float bfhi(unsigned w) { return __uint_as_float(w & 0xffff0000u); }
__device__ __forceinline__ int crow(int r, int hi) { return (r & 3) + 8 * (r >> 2) + 4 * hi; }
__device__ __forceinline__ s16x4 vtr(const LAS unsigned char* p) { return __builtin_bit_cast(s16x4, __builtin_amdgcn_ds_read_tr16_b64_v4i16((LAS v4i16_t*)p)); }
__device__ __forceinline__ bf16x8 cat8(s16x4 lo, s16x4 hi) { return (bf16x8){lo[0], lo[1], lo[2], lo[3], hi[0], hi[1], hi[2], hi[3]}; }
__device__ __forceinline__ void glds16(const void* g, LAS unsigned char* l) { __builtin_amdgcn_global_load_lds((const unsigned*)g, (LAS unsigned*)l, 16, 0, 0); }
__device__ __forceinline__ void glds16a(const void* g, unsigned lds_dst) { unsigned keep; asm volatile("s_mov_b32 %0, m0\n\ts_mov_b32 m0, %2\n\ts_nop 0\n\tglobal_load_lds_dwordx4 %1, off\n\ts_mov_b32 m0, %0" : "=&s"(keep) : "v"(g), "s"(lds_dst) : "memory"); }
#define MFMA32(a, b, c) __builtin_amdgcn_mfma_f32_32x32x16_bf16((a), (b), (c), 0, 0, 0)
#define VMWAIT0() asm volatile("s_waitcnt vmcnt(0)" ::: "memory")
__device__ __forceinline__ float wave_sum(float v) {
#pragma unroll
    for (int o = 1; o < 64; o <<= 1) v += __shfl_xor(v, o);
    return v;
}
__device__ __forceinline__ float half_sum32(float v) {
#pragma unroll
    for (int o = 1; o < 32; o <<= 1) v += __shfl_xor(v, o);
    return v;
}

struct Params { float lam[DEPTH]; float b2[DEPTH]; };

__device__ __forceinline__ void transpose_item(const float* W, int K, int N, bf16* WT, const float* gk, int rowmap, LAS float* scr, int item, int lane) {
    const int nblk = N / 32, kb = item / nblk, nb = item % nblk, k0 = 64 * kb, n0 = 32 * nb;
#pragma unroll 8
    for (int i = 0; i < 32; ++i) { const int kk = 2 * i + (lane >> 5); scr[kk * 33 + (lane & 31)] = W[(size_t)(k0 + kk) * N + n0 + (lane & 31)]; }
    asm volatile("s_waitcnt lgkmcnt(0)" ::: "memory");
    const int c = lane & 7;
    float g8[8];
#pragma unroll
    for (int i = 0; i < 8; ++i) g8[i] = gk ? gk[k0 + 8 * c + i] : 1.0f;
    const int r0 = rowmap == 0 ? n0 : ((n0 >> 7) * 256 + (n0 & 127) + (rowmap == 2 ? 128 : 0));
#pragma unroll
    for (int j = 0; j < 4; ++j) { const int n = (lane >> 3) + 8 * j; const LAS float* s = scr + (8 * c) * 33 + n;
        u32x4 o; o.x = pk2(s[0 * 33] * g8[0], s[1 * 33] * g8[1]); o.y = pk2(s[2 * 33] * g8[2], s[3 * 33] * g8[3]); o.z = pk2(s[4 * 33] * g8[4], s[5 * 33] * g8[5]); o.w = pk2(s[6 * 33] * g8[6], s[7 * 33] * g8[7]);
        *(u32x4*)(WT + (size_t)(r0 + n) * K + k0 + 8 * c) = o; }
    asm volatile("s_waitcnt lgkmcnt(0)" ::: "memory");
}
__device__ __forceinline__ void row_to_bf16_ssq(const float* xrow, bf16* orow, float* ssq, int lane) {
    const f32x4* xr = (const f32x4*)xrow + lane;
    f32x4 v[4]; float s = 0.f;
#pragma unroll
    for (int j = 0; j < 4; ++j) { v[j] = xr[64 * j]; s += (v[j].x * v[j].x + v[j].y * v[j].y) + (v[j].z * v[j].z + v[j].w * v[j].w); }
    s = wave_sum(s);
    unsigned long long* o8 = (unsigned long long*)orow + lane;
#pragma unroll
    for (int j = 0; j < 4; ++j) o8[64 * j] = (unsigned long long)pk2(v[j].x, v[j].y) | ((unsigned long long)pk2(v[j].z, v[j].w) << 32);
    if (lane == 0) *ssq = s;
}

struct Args { const float* in[18]; float* out; unsigned char* ws; int ph_lo, ph_hi; };
struct Frame {
    LAS unsigned char* lds;
    float* out; unsigned char* ws;
    int tid, lane, wave, vcu, G;
};

__device__ __forceinline__ void p0_prologue(Frame& F, const Args& A) {
    LAS float* scr = (LAS float*)(F.lds + F.wave * 16384);
    const int gw = F.vcu * NWAVES + F.wave, NGW = F.G * NWAVES;
    constexpr int I_IN = (DM / 64) * (NPROJ / 32), I_OUT = (DM / 64) * (DM / 32), I_G = (DM / 64) * (FF / 32), I_D = (FF / 64) * (DM / 32);
    constexpr int PER_LAYER = I_IN + I_OUT + 2 * I_G + I_D;
    for (int it = gw; it < DEPTH * PER_LAYER; it += NGW) {
        const int l = it / PER_LAYER; int r = it % PER_LAYER;
        const float* g_attn = A.in[1] + l * DM; const float* g_ffn = A.in[14] + l * DM;
        if (r < I_IN) { transpose_item(A.in[2] + (size_t)l * DM * NPROJ, DM, NPROJ, (bf16*)(F.ws + WS_WIN) + (size_t)l * NPROJ * DM, g_attn, 0, scr, r, F.lane); continue; } r -= I_IN;
        if (r < I_OUT) { transpose_item(A.in[13] + (size_t)l * DM * DM, DM, DM, (bf16*)(F.ws + WS_WOUT) + (size_t)l * DM * DM, nullptr, 0, scr, r, F.lane); continue; } r -= I_OUT;
        if (r < I_G) { transpose_item(A.in[15] + (size_t)l * DM * FF, DM, FF, (bf16*)(F.ws + WS_WGU) + (size_t)l * NGU * DM, g_ffn, 1, scr, r, F.lane); continue; } r -= I_G;
        if (r < I_G) { transpose_item(A.in[16] + (size_t)l * DM * FF, DM, FF, (bf16*)(F.ws + WS_WGU) + (size_t)l * NGU * DM, g_ffn, 2, scr, r, F.lane); continue; } r -= I_G;
        transpose_item(A.in[17] + (size_t)l * FF * DM, FF, DM, (bf16*)(F.ws + WS_WDN) + (size_t)l * DM * FF, nullptr, 0, scr, r, F.lane);
    }
    float* ssq0 = (float*)(F.ws + WS_CTL);
    for (int m = gw; m < M; m += NGW) row_to_bf16_ssq(A.in[0] + (size_t)m * DM, (bf16*)(F.ws + WS_XB) + (size_t)m * DM, ssq0 + m, F.lane);
    if (blockIdx.x == 0 && F.wave == 0) {
        Params* P = (Params*)(F.ws + WS_CTL + PAR_OFF);
        for (int l = 0; l < DEPTH; ++l) {
            const float a = wave_sum(A.in[8][l * 64 + F.lane] * A.in[9][l * 64 + F.lane]), b = wave_sum(A.in[10][l * 64 + F.lane] * A.in[11][l * 64 + F.lane]);
            const float lam_init = 0.8f - 0.6f * expf(-0.3f * (float)l);
            if (F.lane == 0) P->lam[l] = expf(a) - expf(b) + lam_init;
            float gq = fabsf(A.in[6][l * 64 + F.lane]), gk = fabsf(A.in[7][l * 64 + F.lane]);
#pragma unroll
            for (int o = 1; o < 64; o <<= 1) { gq = fmaxf(gq, __shfl_xor(gq, o)); gk = fmaxf(gk, __shfl_xor(gk, o)); }
            if (F.lane == 0) P->b2[l] = 8.0f * LOG2E * 1.02f * gq * gk;
        }
    }
}

__device__ __forceinline__ void qknorm_pass(Frame& F, const Args& A, int l) {
    bf16* PROJ = (bf16*)(F.ws + WS_PROJ);
    const int c = F.tid & 127, sub = F.tid >> 7;
    const bool isq = c < 64; const int d0 = (8 * c) & 63;
    const float* g = (isq ? A.in[6] : A.in[7]) + l * 64 + d0; const float sc = isq ? 0.125f * LOG2E : 1.0f;
    float g8[8];
#pragma unroll
    for (int i = 0; i < 8; ++i) g8[i] = g[i] * sc;
    for (int it = F.vcu; it < M / 4; it += F.G) {
        const int row = 4 * it + sub; u32x4* p = (u32x4*)(PROJ + (size_t)row * NPROJ + C_DQ + 8 * c);
        const u32x4 w = *p; float x[8] = {bflo(w.x), bfhi(w.x), bflo(w.y), bfhi(w.y), bflo(w.z), bfhi(w.z), bflo(w.w), bfhi(w.w)};
        float ss = 0.f;
#pragma unroll
        for (int i = 0; i < 8; ++i) ss += x[i] * x[i];
        ss += __shfl_xor(ss, 1); ss += __shfl_xor(ss, 2); ss += __shfl_xor(ss, 4);
        const float r = __builtin_amdgcn_rsqf(ss * (1.0f / 64.0f) + EPS);
        u32x4 o; o.x = pk2(x[0] * r * g8[0], x[1] * r * g8[1]); o.y = pk2(x[2] * r * g8[2], x[3] * r * g8[3]); o.z = pk2(x[4] * r * g8[4], x[5] * r * g8[5]); o.w = pk2(x[6] * r * g8[6], x[7] * r * g8[7]);
        *p = o;
    }
}
__device__ __forceinline__ int tr_off128(int lane, int r0, int cb) { return (r0 + ((lane & 15) >> 2)) * 128 + (32 * cb + 16 * ((lane >> 4) & 1)) * 2 + 8 * (lane & 3); }

__device__ __forceinline__ void ret_kv_item(Frame& F, const Args& A, int l, int item) {
    const bf16* PROJ = (const bf16*)(F.ws + WS_PROJ);
    const int n = item & 63, h = (item >> 6) & 7, b = item >> 9;
    int lane_ = F.lane; asm volatile("" : "+v"(lane_));
    const int tid_ = (F.wave << 6) | lane_;
    const float lgf2 = -expf(A.in[3][l * RH + h]) * LOG2E, lgb2 = -expf(A.in[4][l * RH + h]) * LOG2E;
    const size_t row0 = (size_t)b * SEQ + (size_t)n * CH;
    LAS unsigned char* LK = F.lds; LAS unsigned char* LVF = F.lds + 16384; LAS unsigned char* LVB = F.lds + 32768;
#pragma unroll
    for (int i = 0; i < 2; ++i) { const int pc = tid_ + 512 * i, s = pc >> 3, ch = pc & 7;
        const u32x4 kw = *(const u32x4*)(PROJ + (row0 + s) * NPROJ + C_RK + h * 64 + 8 * ch);
        const u32x4 vw = *(const u32x4*)(PROJ + (row0 + s) * NPROJ + C_RV + h * 64 + 8 * ch);
        *(LAS u32x4*)(LK + s * 128 + ch * 16) = kw;
        const float wf = __builtin_amdgcn_exp2f(lgf2 * (float)(CH - 1 - s)) * 0.125f, wb = __builtin_amdgcn_exp2f(lgb2 * (float)s) * 0.125f;
        const float x[8] = {bflo(vw.x), bfhi(vw.x), bflo(vw.y), bfhi(vw.y), bflo(vw.z), bfhi(vw.z), bflo(vw.w), bfhi(vw.w)};
        u32x4 a, c2;
        a.x = pk2(x[0] * wf, x[1] * wf); a.y = pk2(x[2] * wf, x[3] * wf); a.z = pk2(x[4] * wf, x[5] * wf); a.w = pk2(x[6] * wf, x[7] * wf);
        c2.x = pk2(x[0] * wb, x[1] * wb); c2.y = pk2(x[2] * wb, x[3] * wb); c2.z = pk2(x[4] * wb, x[5] * wb); c2.w = pk2(x[6] * wb, x[7] * wb);
        *(LAS u32x4*)(LVF + s * 128 + ch * 16) = a; *(LAS u32x4*)(LVB + s * 128 + ch * 16) = c2; }
    __syncthreads();
    const int dir = F.wave >> 2, db = (F.wave >> 1) & 1, eb = F.wave & 1, hi = lane_ >> 5;
    const LAS unsigned char* LV = dir ? LVB : LVF;
    const int tb8 = (8 * hi + ((lane_ & 15) >> 2)) * 128 + 32 * ((lane_ >> 4) & 1) + 8 * (lane_ & 3);
    const LAS unsigned char* pa = LK + tb8 + 64 * db; const LAS unsigned char* pb_ = LV + tb8 + 64 * eb;
    f32x16 acc = {};
#pragma unroll
    for (int st = 0; st < 8; ++st) {
        const bf16x8 a = cat8(vtr(pa + st * 2048), vtr(pa + st * 2048 + 512));
        const bf16x8 bb = cat8(vtr(pb_ + st * 2048), vtr(pb_ + st * 2048 + 512));
        acc = MFMA32(a, bb, acc);
    }
    float* KV = (float*)((unsigned char*)F.out + (dir ? 16 * MiB : 0)) + (size_t)item * 4096;
#pragma unroll
    for (int r = 0; r < 16; ++r) KV[(32 * db + crow(r, hi)) * 64 + 32 * eb + (lane_ & 31)] = acc[r];
    __syncthreads();
}

__device__ __forceinline__ void ret_scan(Frame& F, const Args& A, int l) {
    const int total = 2 * BATCH * RH * 4096;
    for (int gid = F.vcu * 512 + F.tid; gid < total; gid += F.G * 512) {
        const int dir = gid / (BATCH * RH * 4096), rem = gid % (BATCH * RH * 4096), bh = rem >> 12, el = rem & 4095, h = bh & 7;
        const float lg = -expf((dir ? A.in[4] : A.in[3])[l * RH + h]); const float dc = expf(lg * (float)CH);
        const float* KV = (const float*)((unsigned char*)F.out + (dir ? 16 * MiB : 0)) + (size_t)bh * NCH * 4096 + el;
        bf16* R = (bf16*)(F.ws + (dir ? WS_RB : WS_RF)) + (size_t)bh * NCH * 4096 + el;
        float st = 0.f;
        if (dir == 0) {
#pragma unroll 8
            for (int n = 0; n < NCH; ++n) { const float kv = KV[(size_t)n * 4096]; R[(size_t)n * 4096] = (bf16)(pk2(st, 0.f) & 0xffffu); st = dc * st + kv; }
        } else {
#pragma unroll 8
            for (int n = NCH - 1; n >= 0; --n) { const float kv = KV[(size_t)n * 4096]; R[(size_t)n * 4096] = (bf16)(pk2(st, 0.f) & 0xffffu); st = dc * st + kv; }
        }
    }
}

__device__ __forceinline__ void attn_half(Frame& F, const Args& A, int l, int b, int h, int qb, int m) {
    const bf16* PROJ = (const bf16*)(F.ws + WS_PROJ); bf16* OB = (bf16*)((unsigned char*)F.out + 32 * MiB) + (size_t)m * M * 512;
    int lane = F.lane; asm volatile("" : "+v"(lane));
    const int r32 = lane & 31, hi = lane >> 5, wid = F.wave;
    const size_t rowbase = (size_t)b * SEQ; const int q0 = qb * 256 + wid * 32;
    const float B2 = ((const Params*)(F.ws + WS_CTL + PAR_OFF))->b2[l];
    const float slope2 = exp2f(-2.0f * (float)(h + 1)) * LOG2E, nslope2 = -slope2;
    const int dthr = (int)(150.0f / slope2) + 1;
    const int t_lo = max(0, ((qb * 256 - 63 - dthr) >> 6) + 1), t_hi = min(SEQ / 64, (qb * 256 + 255 + dthr + 63) >> 6);
    LAS unsigned char* lds = F.lds;
    LAS float* wsf = (LAS float*)(lds + 73728) + wid * 64;
    const bf16* kvb = PROJ + rowbase * NPROJ;
    const bf16* vsrc = kvb + (size_t)(16 * (wid & 3) + (lane >> 2)) * NPROJ + C_DV + h * 128 + 32 * (wid >> 2) + 8 * (lane & 3);
    const int vlane = ((lane >> 4) & 1) * 32 + (lane & 3) * 8 + (4 * hi + ((lane & 15) >> 2)) * 64;
    const int klane = (r32 >> 3) * 1024 + (r32 & 7) * 128 + ((hi ^ (r32 & 7)) << 4);
    bf16x8 qf[4];
    { const bf16* qrow = PROJ + (rowbase + q0 + r32) * NPROJ + C_DQ + h * 128 + m * 64 + hi * 8;
#pragma unroll
      for (int d0 = 0; d0 < 4; ++d0) qf[d0] = *(const bf16x8*)(qrow + d0 * 16); }
    const bf16* ksrc = kvb + (size_t)(8 * wid + (lane >> 3)) * NPROJ + C_DK + h * 128 + m * 64 + 8 * ((lane & 7) ^ (lane >> 3));
    f32x16 oa[4];
#pragma unroll
    for (int i = 0; i < 4; ++i) oa[i] = f32x16{};
    float ls = 0.f;
    const int n = t_hi - t_lo;
    const int tq = q0 >> 6;
    const unsigned ldsb = (unsigned)(uintptr_t)lds;
    const float dq0 = (float)(q0 + r32 - t_lo * 64 - 4 * hi);
#define DMA_K(i, slot) glds16a(ksrc + (size_t)min(t_lo + (i), SEQ / 64 - 1) * 64 * NPROJ, (unsigned)__builtin_amdgcn_readfirstlane((int)(ldsb + (slot) * 8192 + wid * 1024)))
#define DMA_V(i, slot) do { const bf16* v_ = vsrc + (size_t)min(t_lo + (i), SEQ / 64 - 1) * 64 * NPROJ; const unsigned d_ = (unsigned)__builtin_amdgcn_readfirstlane((int)(ldsb + 24576 + (slot) * 16384 + wid * 1024)); glds16a(v_, d_); glds16a(v_ + 64, d_ + 8192); } while (0)
#define KADDR(p, d0) ((const LAS unsigned char*)(uintptr_t)((unsigned)(uintptr_t)(p) ^ (unsigned)((d0) << 5)))
#define BIAS(S0, S1, i) do { const float dq_ = dq0 - 64.0f * (float)(i); _Pragma("unroll") for (int r = 0; r < 16; ++r) { const float c = (float)((r & 3) + 8 * (r >> 2)); \
        S0[r] = nslope2 * fabsf(dq_ - c) - B2; S1[r] = nslope2 * fabsf(dq_ - (c + 32.0f)) - B2; } } while (0)
#define QK_ACC(S0, S1, slot) do { const LAS unsigned char* kp_ = lds + (slot) * 8192 + klane; _Pragma("unroll") for (int d0 = 0; d0 < 4; ++d0) { \
        const LAS unsigned char* ka_ = KADDR(kp_, d0); const bf16x8 b0 = *(const LAS bf16x8*)(ka_); const bf16x8 b1 = *(const LAS bf16x8*)(ka_ + 4096); \
        S0 = MFMA32(b0, qf[d0], S0); S1 = MFMA32(b1, qf[d0], S1); } } while (0)
#define FENCE() __builtin_amdgcn_sched_barrier(0)
#define EXP4(C, k, s_) do { C[k] = __builtin_amdgcn_exp2f(C[k]); C[(k) + 1] = __builtin_amdgcn_exp2f(C[(k) + 1]); C[(k) + 2] = __builtin_amdgcn_exp2f(C[(k) + 2]); C[(k) + 3] = __builtin_amdgcn_exp2f(C[(k) + 3]); \
        s_ += (C[k] + C[(k) + 1]) + (C[(k) + 2] + C[(k) + 3]); } while (0)
#define PACK8(C, k) (u32x4){pk2(C[k], C[(k) + 1]), pk2(C[(k) + 2], C[(k) + 3]), pk2(C[(k) + 4], C[(k) + 5]), pk2(C[(k) + 6], C[(k) + 7])}
#define KLD(dst0, dst1, d0) do { const LAS unsigned char* ka_ = KADDR(kp_, d0); dst0 = *(const LAS bf16x8*)(ka_); dst1 = *(const LAS bf16x8*)(ka_ + 4096); } while (0)
#define VLD(dst, off) dst = cat8(vtr(vb_ + (off)), vtr(vb_ + (off) + 512))
#define BIAS4(S0, S1, k, dq_) do { if (strad_) { _Pragma("unroll") for (int r = (k); r < (k) + 4; ++r) { const float c = (float)((r & 3) + 8 * (r >> 2)); \
        S0[r] = nslope2 * fabsf(dq_ - c) - B2; S1[r] = nslope2 * fabsf(dq_ - (c + 32.0f)) - B2; } } \
      else { BIAS4F_##k(S0, S1); } } while (0)
#define FMK(dst, base, K) do { float t_; asm("v_fmamk_f32 %0, %1, " #K ", %2" : "=v"(t_) : "v"(sg_), "v"(base)); dst = t_; } while (0)
#define BIAS4F_0(S0, S1) do { FMK(S0[0], base0_, 0x00000000); FMK(S1[0], base1_, 0x00000000); FMK(S0[1], base0_, 0x3f800000); FMK(S1[1], base1_, 0x3f800000); FMK(S0[2], base0_, 0x40000000); FMK(S1[2], base1_, 0x40000000); FMK(S0[3], base0_, 0x40400000); FMK(S1[3], base1_, 0x40400000); } while (0)
#define BIAS4F_4(S0, S1) do { FMK(S0[4], base0_, 0x41000000); FMK(S1[4], base1_, 0x41000000); FMK(S0[5], base0_, 0x41100000); FMK(S1[5], base1_, 0x41100000); FMK(S0[6], base0_, 0x41200000); FMK(S1[6], base1_, 0x41200000); FMK(S0[7], base0_, 0x41300000); FMK(S1[7], base1_, 0x41300000); } while (0)
#define BIAS4F_8(S0, S1) do { FMK(S0[8], base0_, 0x41800000); FMK(S1[8], base1_, 0x41800000); FMK(S0[9], base0_, 0x41880000); FMK(S1[9], base1_, 0x41880000); FMK(S0[10], base0_, 0x41900000); FMK(S1[10], base1_, 0x41900000); FMK(S0[11], base0_, 0x41980000); FMK(S1[11], base1_, 0x41980000); } while (0)
#define BIAS4F_12(S0, S1) do { FMK(S0[12], base0_, 0x41c00000); FMK(S1[12], base1_, 0x41c00000); FMK(S0[13], base0_, 0x41c80000); FMK(S1[13], base1_, 0x41c80000); FMK(S0[14], base0_, 0x41d00000); FMK(S1[14], base1_, 0x41d00000); FMK(S0[15], base0_, 0x41d80000); FMK(S1[15], base1_, 0x41d80000); } while (0)
#define STEP(C0, C1, N0, N1, i) do { \
        DMA_K((i) + 3, r0); DMA_V((i) + 2, r2);     \
        const LAS unsigned char* kp_ = lds + r1 * 8192 + klane; \
        const LAS unsigned char* vb_ = lds + 24576 + r0 * 16384 + vlane; \
        const float dq2_ = dq0 - 64.0f * (float)((i) + 2); \
        const int tt_ = t_lo + (i) + 2; const bool strad_ = (tt_ == tq); const float sg_ = (tt_ < tq) ? slope2 : nslope2; const float base0_ = -sg_ * dq2_ - B2, base1_ = base0_ + 32.0f * sg_; \
        float s_ = 0.f; bf16x8 ka0, ka1, va, vb2, vc, vd; u32x4 pw0, pw1, pw2, pw3; \
        KLD(ka0, ka1, 0); \
        FENCE(); \
          \
        N0 = MFMA32(ka0, qf[0], N0); N1 = MFMA32(ka1, qf[0], N1); KLD(ka0, ka1, 1); EXP4(C0, 0, s_); FENCE(); \
        N0 = MFMA32(ka0, qf[1], N0); N1 = MFMA32(ka1, qf[1], N1); KLD(ka0, ka1, 2); EXP4(C0, 4, s_); pw0 = PACK8(C0, 0); FENCE(); \
        N0 = MFMA32(ka0, qf[2], N0); N1 = MFMA32(ka1, qf[2], N1); KLD(ka0, ka1, 3); EXP4(C0, 8, s_); FENCE(); \
        N0 = MFMA32(ka0, qf[3], N0); N1 = MFMA32(ka1, qf[3], N1); VLD(va, 0); VLD(vb2, 4096); EXP4(C0, 12, s_); pw1 = PACK8(C0, 8); FENCE(); \
          \
        VLD(vc, 8192); VLD(vd, 12288); oa[0] = MFMA32(__builtin_bit_cast(bf16x8, pw0), va, oa[0]); oa[1] = MFMA32(__builtin_bit_cast(bf16x8, pw0), vb2, oa[1]); EXP4(C1, 0, s_); FENCE(); \
        VLD(va, 1024); VLD(vb2, 5120); oa[2] = MFMA32(__builtin_bit_cast(bf16x8, pw0), vc, oa[2]); oa[3] = MFMA32(__builtin_bit_cast(bf16x8, pw0), vd, oa[3]); EXP4(C1, 4, s_); pw2 = PACK8(C1, 0); FENCE(); \
        VLD(vc, 9216); VLD(vd, 13312); oa[0] = MFMA32(__builtin_bit_cast(bf16x8, pw1), va, oa[0]); oa[1] = MFMA32(__builtin_bit_cast(bf16x8, pw1), vb2, oa[1]); EXP4(C1, 8, s_); FENCE(); \
        VLD(va, 2048); VLD(vb2, 6144); oa[2] = MFMA32(__builtin_bit_cast(bf16x8, pw1), vc, oa[2]); oa[3] = MFMA32(__builtin_bit_cast(bf16x8, pw1), vd, oa[3]); EXP4(C1, 12, s_); pw3 = PACK8(C1, 8); FENCE(); \
        ls += s_; \
        VLD(vc, 10240); VLD(vd, 14336); oa[0] = MFMA32(__builtin_bit_cast(bf16x8, pw2), va, oa[0]); oa[1] = MFMA32(__builtin_bit_cast(bf16x8, pw2), vb2, oa[1]); BIAS4(C0, C1, 0, dq2_); FENCE(); \
        VLD(va, 3072); VLD(vb2, 7168); oa[2] = MFMA32(__builtin_bit_cast(bf16x8, pw2), vc, oa[2]); oa[3] = MFMA32(__builtin_bit_cast(bf16x8, pw2), vd, oa[3]); BIAS4(C0, C1, 4, dq2_); FENCE(); \
        VLD(vc, 11264); VLD(vd, 15360); oa[0] = MFMA32(__builtin_bit_cast(bf16x8, pw3), va, oa[0]); oa[1] = MFMA32(__builtin_bit_cast(bf16x8, pw3), vb2, oa[1]); BIAS4(C0, C1, 8, dq2_); FENCE(); \
        oa[2] = MFMA32(__builtin_bit_cast(bf16x8, pw3), vc, oa[2]); oa[3] = MFMA32(__builtin_bit_cast(bf16x8, pw3), vd, oa[3]); BIAS4(C0, C1, 12, dq2_); FENCE(); \
        asm volatile("s_waitcnt vmcnt(3)" ::: "memory"); \
        __syncthreads(); { const int t_ = r0; r0 = r1; r1 = r2; r2 = t_; } } while (0)
    f32x16 A0, A1, B0, B1;
    if (wid >= 4) __builtin_amdgcn_s_setprio(1);
    int r0 = 0, r1 = 1, r2 = 2;
    DMA_K(0, 0); DMA_V(0, 0); DMA_K(1, 1); DMA_V(1, 1); DMA_K(2, 2);
    BIAS(A0, A1, 0);
    VMWAIT0(); __syncthreads();
    { const LAS unsigned char* kp_ = lds + klane; _Pragma("unroll") for (int d0 = 0; d0 < 4; ++d0) {
        const LAS unsigned char* ka_ = KADDR(kp_, d0); const bf16x8 b0 = *(const LAS bf16x8*)(ka_); const bf16x8 b1 = *(const LAS bf16x8*)(ka_ + 4096);
        A0 = MFMA32(b0, qf[d0], A0); A1 = MFMA32(b1, qf[d0], A1); } }
    BIAS(B0, B1, 1);
    asm volatile("s_waitcnt lgkmcnt(0)" ::: "memory"); __syncthreads();
#pragma unroll 1
    for (int i = 0;; i += 2) {
        STEP(A0, A1, B0, B1, i);
        if (i + 1 >= n) break;
        STEP(B0, B1, A0, A1, i + 1);
        if (i + 2 >= n) break;
    }
    VMWAIT0();
    __builtin_amdgcn_s_setprio(0);
#undef DMA_K
#undef DMA_V
#undef BIAS
#undef QK_ACC
#undef KADDR
#undef STEP
#undef FENCE
#undef EXP4
#undef PACK8
#undef KLD
#undef VLD
#undef BIAS4
    ls += __shfl_xor(ls, 32);
    int le = lane; asm volatile("" : "+v"(le));
    const int r32e = le & 31, hie = le >> 5;
    if (hie == 0) wsf[r32e] = 1.0f / ls;
    asm volatile("s_waitcnt lgkmcnt(0)" ::: "memory");
#pragma unroll
    for (int r = 0; r < 16; ++r) {
        const int qr = crow(r, hie); const float a1 = wsf[qr];
        bf16* orow = OB + (rowbase + q0 + qr) * 512 + h * 128 + r32e;
#pragma unroll
        for (int db = 0; db < 4; ++db) orow[32 * db] = (bf16)(pk2(oa[db][r] * a1, 0.f) & 0xffffu);
        asm volatile("" ::: "memory");
    }
    __syncthreads();
}
__device__ __forceinline__ void attn_combine(Frame& F, const Args& A, int l) {
    const bf16* OB0 = (const bf16*)((unsigned char*)F.out + 32 * MiB); const bf16* OB1 = OB0 + (size_t)M * 512; bf16* MIX = (bf16*)(F.ws + WS_MIX);
    const Params* P = (const Params*)(F.ws + WS_CTL + PAR_OFF);
    const float lam = P->lam[l], post = 1.0f - (0.8f - 0.6f * expf(-0.3f * (float)l));
    const int c16 = F.tid & 15, grp = F.tid >> 4;
    float g8[8];
#pragma unroll
    for (int i = 0; i < 8; ++i) g8[i] = A.in[12][l * 128 + 8 * c16 + i] * post;
    for (int it = F.vcu; it < M * 4 / 32; it += F.G) {
        const int gi = it * 32 + grp, row = gi >> 2, h = gi & 3;
        const size_t off = (size_t)row * 512 + h * 128 + 8 * c16;
        const u32x4 a = *(const u32x4*)(OB0 + off), bq = *(const u32x4*)(OB1 + off);
        float v[8] = {bflo(a.x) - lam * bflo(bq.x), bfhi(a.x) - lam * bfhi(bq.x), bflo(a.y) - lam * bflo(bq.y), bfhi(a.y) - lam * bfhi(bq.y),
                      bflo(a.z) - lam * bflo(bq.z), bfhi(a.z) - lam * bfhi(bq.z), bflo(a.w) - lam * bflo(bq.w), bfhi(a.w) - lam * bfhi(bq.w)};
        float ss = 0.f;
#pragma unroll
        for (int i = 0; i < 8; ++i) ss += v[i] * v[i];
        ss += __shfl_xor(ss, 1); ss += __shfl_xor(ss, 2); ss += __shfl_xor(ss, 4); ss += __shfl_xor(ss, 8);
        const float rs = __builtin_amdgcn_rsqf(ss * (1.0f / 128.0f) + EPS);
        u32x4 o; o.x = pk2(v[0] * rs * g8[0], v[1] * rs * g8[1]); o.y = pk2(v[2] * rs * g8[2], v[3] * rs * g8[3]); o.z = pk2(v[4] * rs * g8[4], v[5] * rs * g8[5]); o.w = pk2(v[6] * rs * g8[6], v[7] * rs * g8[7]);
        *(u32x4*)(MIX + (size_t)row * DM + 512 + h * 128 + 8 * c16) = o;
    }
}

__device__ __forceinline__ void ret_out_pair(Frame& F, const Args& A, int l, int pair) {
    const bf16* PROJ = (const bf16*)(F.ws + WS_PROJ); bf16* MIX = (bf16*)(F.ws + WS_MIX);
    int lane = F.lane; asm volatile("" : "+v"(lane));
    const int r32 = lane & 31, hi = lane >> 5, grp = F.wave >> 2, wq = F.wave & 3, gt = (wq << 6) | lane;
    const int item = 2 * pair + grp; const int n = item & 63, h = (item >> 6) & 7, b = item >> 9;
    const float lgf2 = -expf(A.in[3][l * RH + h]) * LOG2E, lgb2 = -expf(A.in[4][l * RH + h]) * LOG2E;
    const size_t row0 = (size_t)b * SEQ + (size_t)n * CH;
    LAS unsigned char* LK = F.lds + grp * 49152; LAS unsigned char* LV = LK + 16384; LAS unsigned char* LRF = LK + 32768; LAS unsigned char* LRB = LK + 40960;
    const bf16* RF = (const bf16*)(F.ws + WS_RF) + (size_t)item * 4096; const bf16* RB = (const bf16*)(F.ws + WS_RB) + (size_t)item * 4096;
#pragma unroll
    for (int i = 0; i < 4; ++i) { const int pc = gt + 256 * i, s = pc >> 3, ch = pc & 7;
        *(LAS u32x4*)(LV + s * 128 + ch * 16) = *(const u32x4*)(PROJ + (row0 + s) * NPROJ + C_RV + h * 64 + 8 * ch);
        *(LAS u32x4*)(LK + s * 128 + ((ch ^ (s & 7)) << 4)) = *(const u32x4*)(PROJ + (row0 + s) * NPROJ + C_RK + h * 64 + 8 * ch); }
#pragma unroll
    for (int i = 0; i < 2; ++i) { const int pc = gt + 256 * i;
        *(LAS u32x4*)(LRF + pc * 16) = *(const u32x4*)(RF + pc * 8); *(LAS u32x4*)(LRB + pc * 16) = *(const u32x4*)(RB + pc * 8); }
    const int t0 = 32 * wq;
    LAS unsigned char* GW = F.lds + 98304 + F.wave * 4096;
#pragma unroll
    for (int i = 0; i < 4; ++i) { const int pc = lane + 64 * i, rw = pc >> 3, ch = pc & 7;
        *(LAS u32x4*)(GW + rw * 128 + ch * 16) = *(const u32x4*)(PROJ + (row0 + t0 + rw) * NPROJ + C_RG + h * 64 + 8 * ch); }
    bf16x8 qf[4];
    { const bf16* qrow = PROJ + (row0 + t0 + r32) * NPROJ + C_RQ + h * 64 + hi * 8;
#pragma unroll
      for (int d0 = 0; d0 < 4; ++d0) qf[d0] = *(const bf16x8*)(qrow + d0 * 16); }
    __syncthreads();
    f32x16 X[4];
    const unsigned kb0 = (unsigned)(uintptr_t)LK + (unsigned)(r32 * 128 + ((hi ^ (r32 & 7)) << 4));
#pragma unroll
    for (int sb = 0; sb < 4; ++sb) { X[sb] = f32x16{};
#pragma unroll
        for (int d0 = 0; d0 < 4; ++d0) { const bf16x8 kf = *(const LAS bf16x8*)(uintptr_t)((kb0 + sb * 4096) ^ (unsigned)(d0 << 5)); X[sb] = MFMA32(kf, qf[d0], X[sb]); } }
    u32x4 pw[8];
    const float tf = (float)(t0 + r32);
#pragma unroll
    for (int sb = 0; sb < 4; ++sb) {
#pragma unroll
        for (int r = 0; r < 16; ++r) { const float dl = tf - (float)(32 * sb + crow(r, hi)); const float e = lgf2 * fmaxf(dl, 0.f) + lgb2 * fmaxf(-dl, 0.f); X[sb][r] *= __builtin_amdgcn_exp2f(e - 3.0f); }
        pw[2 * sb] = (u32x4){pk2(X[sb][0], X[sb][1]), pk2(X[sb][2], X[sb][3]), pk2(X[sb][4], X[sb][5]), pk2(X[sb][6], X[sb][7])};
        pw[2 * sb + 1] = (u32x4){pk2(X[sb][8], X[sb][9]), pk2(X[sb][10], X[sb][11]), pk2(X[sb][12], X[sb][13]), pk2(X[sb][14], X[sb][15])};
    }
    __builtin_amdgcn_sched_barrier(0);
    const int q4 = (lane & 15) >> 2, tcol = 32 * ((lane >> 4) & 1) + 8 * (lane & 3);
    const LAS unsigned char* pv = LV + (4 * hi + q4) * 128 + tcol;
    const LAS unsigned char* prf = LRF + (8 * hi + q4) * 128 + tcol;
    const LAS unsigned char* prb = LRB + (8 * hi + q4) * 128 + tcol;
    f32x16 aI[2], aF[2], aB[2];
#pragma unroll
    for (int eb = 0; eb < 2; ++eb) { aI[eb] = f32x16{};
#pragma unroll
        for (int ks = 0; ks < 8; ++ks) {
            const bf16x8 vf = cat8(vtr(pv + ks * 2048 + 64 * eb), vtr(pv + ks * 2048 + 1024 + 64 * eb));
            aI[eb] = MFMA32(__builtin_bit_cast(bf16x8, pw[ks]), vf, aI[eb]); } }
    __builtin_amdgcn_sched_barrier(0);
#pragma unroll
    for (int eb = 0; eb < 2; ++eb) { aF[eb] = f32x16{}; aB[eb] = f32x16{};
#pragma unroll
        for (int d0 = 0; d0 < 4; ++d0) {
            const bf16x8 rf = cat8(vtr(prf + d0 * 2048 + 64 * eb), vtr(prf + d0 * 2048 + 512 + 64 * eb));
            const bf16x8 rb = cat8(vtr(prb + d0 * 2048 + 64 * eb), vtr(prb + d0 * 2048 + 512 + 64 * eb));
            aF[eb] = MFMA32(qf[d0], rf, aF[eb]); aB[eb] = MFMA32(qf[d0], rb, aB[eb]); } }
    __builtin_amdgcn_sched_barrier(0);
    const float* rng = A.in[5] + l * 64; const float g0 = rng[r32], g1 = rng[32 + r32];
#pragma unroll
    for (int r = 0; r < 16; ++r) {
        const int tl = t0 + crow(r, hi);
        const float wf = __builtin_amdgcn_exp2f(lgf2 * (float)(tl + 1)), wb = __builtin_amdgcn_exp2f(lgb2 * (float)(CH - tl));
        const float v0 = aI[0][r] + wf * aF[0][r] + wb * aB[0][r], v1 = aI[1][r] + wf * aF[1][r] + wb * aB[1][r];
        const float ss = half_sum32(v0 * v0 + v1 * v1); const float rs = __builtin_amdgcn_rsqf(ss * (1.0f / 64.0f) + EPS);
        const LAS unsigned short* grow = (const LAS unsigned short*)(GW + crow(r, hi) * 128) + r32;
        const float ga = bf2f(grow[0]), gb = bf2f(grow[32]);
        const float sa = ga * __builtin_amdgcn_rcpf(1.0f + __builtin_amdgcn_exp2f(-LOG2E * ga)), sb2 = gb * __builtin_amdgcn_rcpf(1.0f + __builtin_amdgcn_exp2f(-LOG2E * gb));
        LAS unsigned short* orow = (LAS unsigned short*)(GW + crow(r, hi) * 128) + r32;
        orow[0] = (unsigned short)(pk2(v0 * rs * g0 * sa, 0.f) & 0xffffu); orow[32] = (unsigned short)(pk2(v1 * rs * g1 * sb2, 0.f) & 0xffffu);
    }
    asm volatile("s_waitcnt lgkmcnt(0)" ::: "memory");
#pragma unroll
    for (int i = 0; i < 4; ++i) { const int pc = lane + 64 * i, rw = pc >> 3, ch = pc & 7;
        *(u32x4*)(MIX + (row0 + t0 + rw) * DM + h * 64 + 8 * ch) = *(const LAS u32x4*)(GW + rw * 128 + ch * 16); }
    __syncthreads();
}

#define XB_TMO      128
#define XB_XCNT(j)  (256  + 64 * (j))
#define XB_XSUB(j)  (1280 + 64 * (j))
#define XB_XGEN(j)  (2304 + 64 * (j))
#define XB_TOP      3328
#define XB_TOPGEN   3392
#define XCD_BAR_WORDS 3456
#define XB_SPIN_CAP (1u << 18)

__device__ __forceinline__ unsigned xb_ld(unsigned* p)              { return __hip_atomic_load(p, __ATOMIC_RELAXED, __HIP_MEMORY_SCOPE_AGENT); }
__device__ __forceinline__ unsigned xb_add(unsigned* p, unsigned v) { return __hip_atomic_fetch_add(p, v, __ATOMIC_RELAXED, __HIP_MEMORY_SCOPE_AGENT); }
__device__ __forceinline__ unsigned xb_xcc_id() { return (unsigned)__builtin_amdgcn_s_getreg((3 << 11) | 20) & 0xFu; }
#define XB_SPIN(cond, bar) do { unsigned _sp = 0; while (cond) { __builtin_amdgcn_s_sleep(1); \
    if ((++_sp & 255u) == 0u) { if (xb_ld(&(bar)[XB_TMO])) break; if (_sp > XB_SPIN_CAP) { atomicAdd(&(bar)[XB_TMO], 1u); break; } } } } while (0)

struct XcdBarrier {
    unsigned* bar; unsigned x;
    volatile LAS unsigned* st;
};

__device__ __forceinline__ XcdBarrier xcd_barrier_post(unsigned* bar, volatile LAS unsigned* st) {
    XcdBarrier b; b.bar = bar; b.x = xb_xcc_id(); b.st = st;
    if (threadIdx.x == 0) (void)xb_add(&bar[XB_XCNT(b.x)], 1u);
    return b;
}
__device__ __forceinline__ void xcd_barrier_complete(unsigned* bar, unsigned x, unsigned& nloc, unsigned& nx) {
    const unsigned G = gridDim.x * gridDim.y * gridDim.z;
    unsigned sum, cnt, mine, sp = 0u;
    for (;;) {
        sum = 0u; cnt = 0u; mine = 0u;
#pragma unroll
        for (unsigned j = 0; j < 16; ++j) { const unsigned c = xb_ld(&bar[XB_XCNT(j)]); sum += c; cnt += (c > 0u) ? 1u : 0u; mine = (j == x) ? c : mine; }
        if (sum == G) break;
        __builtin_amdgcn_s_sleep(1);
        if ((++sp & 255u) == 0u) { if (xb_ld(&bar[XB_TMO])) break; if (sp > XB_SPIN_CAP) { atomicAdd(&bar[XB_TMO], 1u); break; } }
    }
    nloc = mine > 0u ? mine : 1u; nx = cnt > 0u ? cnt : 1u;
}

__device__ __forceinline__ void xcd_barrier(const XcdBarrier& b) {
    asm volatile("s_waitcnt vmcnt(0)" ::: "memory");
    __syncthreads();
    if (threadIdx.x == 0) {
        unsigned* bar = b.bar;
        __builtin_amdgcn_s_waitcnt(0);
        unsigned nloc = b.st[0], nx = b.st[1];
        if (nloc == 0u) { xcd_barrier_complete(bar, b.x, nloc, nx); b.st[0] = nloc; b.st[1] = nx; }
        const unsigned old = xb_add(&bar[XB_XSUB(b.x)], 1u);
        const unsigned gen = old / nloc;
        if (old + 1u == (gen + 1u) * nloc) {
            __builtin_amdgcn_fence(__ATOMIC_RELEASE, "agent");
            asm volatile("s_waitcnt vmcnt(0)" ::: "memory");
            const unsigned og = xb_add(&bar[XB_TOP], 1u);
            const unsigned tg = og / nx;
            if (og + 1u == (tg + 1u) * nx) xb_add(&bar[XB_TOPGEN], 1u);
            else XB_SPIN(xb_ld(&bar[XB_TOPGEN]) == tg, bar);
            __builtin_amdgcn_fence(__ATOMIC_ACQUIRE, "agent");
            xb_add(&bar[XB_XGEN(b.x)], 1u);
            asm volatile("s_waitcnt vmcnt(0)" ::: "memory");
        } else {
            XB_SPIN(xb_ld(&bar[XB_XGEN(b.x)]) == gen, bar);
            __builtin_amdgcn_fence(__ATOMIC_ACQUIRE, "agent");
            asm volatile("s_waitcnt vmcnt(0)" ::: "memory");
        }
    }
    __syncthreads();
}

constexpr int N_PHASES = 1 + 7 * DEPTH;

__global__ void __launch_bounds__(NWAVES * 64, 2) fwd_megakernel(Args args) {
    extern __shared__ __attribute__((aligned(1024))) unsigned char lds_raw[];
    cg::grid_group grid = cg::this_grid();
    Frame F0;
    F0.lds = (LAS unsigned char*)lds_raw;
    F0.tid = threadIdx.x; F0.lane = F0.tid & 63; F0.wave = __builtin_amdgcn_readfirstlane(F0.tid >> 6);
    F0.G = gridDim.x; { const int bx0 = blockIdx.x; F0.vcu = (F0.G % 8 == 0) ? (bx0 % 8) * (F0.G / 8) + bx0 / 8 : bx0; }
    F0.out = args.out; F0.ws = args.ws;
    const int lo = args.ph_lo, hi = args.ph_hi;
    for (int u = threadIdx.x; u < 64; u += NWAVES * 64) ((LAS unsigned*)(F0.lds + LDS_MISC))[u] = 0u;
    __syncthreads();
    (void)xcd_barrier_post((unsigned*)(args.ws + WS_CTL + BAR_OFF), (volatile LAS unsigned*)(F0.lds + LDS_MISC) + 8);
#define IN(k) (lo <= (k) && (k) < hi)
    if (lo < 0) grid.sync();
#define xcd_seam() do { if (IN(pb + 3)) { unsigned char* w_ = args.ws; asm volatile("" : "+s"(w_)); XcdBarrier b_; b_.bar = (unsigned*)(w_ + WS_CTL + BAR_OFF); b_.x = xb_xcc_id(); b_.st = (volatile LAS unsigned*)(F0.lds + LDS_MISC) + 8; xcd_barrier(b_); } } while (0)
#define SEAM(k) do { if (IN(k) && IN((k) + 1)) { unsigned char* w_ = args.ws; asm volatile("" : "+s"(w_)); XcdBarrier b_; b_.bar = (unsigned*)(w_ + WS_CTL + BAR_OFF); b_.x = xb_xcc_id(); b_.st = (volatile LAS unsigned*)(F0.lds + LDS_MISC) + 8; xcd_barrier(b_); } } while (0)
#define PH_BEGIN() Frame F = F0; int bx = (int)blockIdx.x; asm volatile("" : "+s"(F.ws), "+s"(F.out), "+s"(F.G), "+s"(F.vcu), "+s"(bx), "+s"(F.wave), "+v"(F.lane)); F.tid = (F.wave << 6) | F.lane; \
    float* SSQ = (float*)(F.ws + WS_CTL); bf16* XB = (bf16*)(F.ws + WS_XB); bf16* PROJ = (bf16*)(F.ws + WS_PROJ); bf16* MIX = (bf16*)(F.ws + WS_MIX); bf16* HID = (bf16*)(F.ws + WS_HID); \
    (void)SSQ; (void)XB; (void)PROJ; (void)MIX; (void)HID; (void)bx;
#ifndef SKIP_P0
    if (IN(0)) { PH_BEGIN(); p0_prologue(F, args); }
#endif
    SEAM(0);
#pragma unroll
    for (int l = 0; l < DEPTH; ++l) {
        const int pb = 1 + 7 * l;
#ifndef SKIP_G1
        if (IN(pb)) {
            PH_BEGIN();
            pg8::Gemm g{XB, (const bf16*)(F.ws + WS_WIN) + (size_t)l * NPROJ * DM, M, NPROJ, DM}; pg8::StaticOrder S; S.init(M, NPROJ, F.G, bx, WGM_IN);
            pg8::EpiProj E{PROJ, NPROJ, SSQ + (size_t)(2 * l) * M};
            pg8::gemm_phase<pg8::EpiProj, pg8::StaticOrder, true, true>(F.lds, g, S, E, F.tid);
        }
#endif
        SEAM(pb);
        if (IN(pb + 1)) {
            PH_BEGIN();
#ifndef SKIP_RKV
            for (int it = F.vcu; it < BATCH * RH * NCH; it += F.G) ret_kv_item(F, args, l, it);
#endif
            qknorm_pass(F, args, l);
        } SEAM(pb + 1);
        if (IN(pb + 2)) { PH_BEGIN(); ret_scan(F, args, l); } SEAM(pb + 2);
        if (IN(pb + 3)) {
            PH_BEGIN();
#pragma unroll 1
            for (int it = F.vcu; it < 512; it += F.G) {
                const int k = it >> 8, v = it & 255, x = v >> 5, j = v & 31, bb = (x >> 1) & 1, mm = x >> 2;
                const int hh = k == 0 ? 3 - (x & 1) : ((x & 1) ? 1 : 0), qq = (k == 1 && (x & 1)) ? ((j + 16) & 31) : j;
                attn_half(F, args, l, bb, hh, qq, mm);
            }
            {
                const bool g256 = (F.G == 256); const bool take = g256 ? !((F.vcu >> 5) & 1) : true;
                const int rs = g256 ? ((F.vcu >> 6) * 32 + (F.vcu & 31)) : F.vcu, rstride = g256 ? 128 : F.G;
                if (take) {
#pragma unroll 1
                    for (int pr = rs; pr < BATCH * RH * NCH / 2; pr += rstride) ret_out_pair(F, args, l, pr);
                }
            }
        } xcd_seam();
        if (IN(pb + 3)) { PH_BEGIN(); attn_combine(F, args, l); }
        SEAM(pb + 3);
#ifndef SKIP_G2
        if (IN(pb + 4)) {
            PH_BEGIN();
            pg8::Gemm g{MIX, (const bf16*)(F.ws + WS_WOUT) + (size_t)l * DM * DM, M, DM, DM}; pg8::StaticOrder S; S.init(M, DM, F.G, bx, WGM_SQ);
            pg8::EpiRes E{XB, nullptr, SSQ + (size_t)(2 * l + 1) * M};
            pg8::gemm_phase<pg8::EpiRes, pg8::StaticOrder, true, true>(F.lds, g, S, E, F.tid);
        }
#endif
        SEAM(pb + 4);
#ifndef SKIP_G3
        if (IN(pb + 5)) {
            PH_BEGIN();
            pg8::Gemm g{XB, (const bf16*)(F.ws + WS_WGU) + (size_t)l * NGU * DM, M, NGU, DM}; pg8::StaticOrder S; S.init(M, NGU, F.G, bx, WGM_GU);
            pg8::EpiSwiglu E{HID, FF, SSQ + (size_t)(2 * l + 1) * M};
            pg8::gemm_phase<pg8::EpiSwiglu, pg8::StaticOrder, true, true>(F.lds, g, S, E, F.tid);
        }
#endif
        SEAM(pb + 5);
#ifndef SKIP_G4
        if (IN(pb + 6)) {
            PH_BEGIN();
            pg8::Gemm g{HID, (const bf16*)(F.ws + WS_WDN) + (size_t)l * DM * FF, M, DM, FF}; pg8::StaticOrder S; S.init(M, DM, F.G, bx, WGM_SQ);
            const bool last = (l == DEPTH - 1);
            pg8::EpiRes E{XB, last ? F.out : nullptr, SSQ + (size_t)(2 * l + 2 < 4 ? 2 * l + 2 : 0) * M};
            pg8::gemm_phase<pg8::EpiRes, pg8::StaticOrder, true, true>(F.lds, g, S, E, F.tid);
        }
#endif
        SEAM(pb + 6);
    }
#undef IN
#undef SEAM
}

#ifndef MK_N_LAUNCHES
#define MK_N_LAUNCHES 1
#endif
extern "C" void kernel_launch(void* const* d_in, const int* in_sizes, int n_in, void* d_out, int out_size, void* d_ws, size_t ws_size, hipStream_t stream) {
    static int grid = 0;
    if (grid == 0) {
        if (n_in != 18 || out_size != M * DM || ws_size < WS_END) { fprintf(stderr, "kernel_launch: unexpected shapes (n_in %d out %d ws %zu)\n", n_in, out_size, ws_size); grid = -1; return; }
        int dev = 0, cus = 0, per_cu = 0;
        hipGetDevice(&dev); hipDeviceGetAttribute(&cus, hipDeviceAttributeMultiprocessorCount, dev);
        if (hipFuncSetAttribute((const void*)fwd_megakernel, hipFuncAttributeMaxDynamicSharedMemorySize, LDS_BYTES) != hipSuccess) { fprintf(stderr, "kernel_launch: hipFuncSetAttribute failed\n"); grid = -1; return; }
        if (hipOccupancyMaxActiveBlocksPerMultiprocessor(&per_cu, (const void*)fwd_megakernel, NWAVES * 64, LDS_BYTES) != hipSuccess || per_cu < 1) { fprintf(stderr, "kernel_launch: occupancy query failed (%d)\n", per_cu); (void)hipGetLastError(); per_cu = 1; }
        grid = cus * per_cu;
    }
    if (grid < 0) return;
    hipMemsetAsync((char*)d_ws + WS_CTL, 0, CTL_BYTES, stream);
    Args a{};
    for (int i = 0; i < 18; ++i) a.in[i] = (const float*)d_in[i];
    a.out = (float*)d_out; a.ws = (unsigned char*)d_ws;
    const int nl = MK_N_LAUNCHES;
    for (int li = 0; li < nl; ++li) {
        a.ph_lo = (nl == 1) ? 0 : li; a.ph_hi = (nl == 1) ? N_PHASES : li + 1;
        void* kargs[] = {&a};
        hipError_t e = hipLaunchCooperativeKernel((const void*)fwd_megakernel, dim3(grid), dim3(NWAVES * 64), kargs, LDS_BYTES, stream);
        if (e != hipSuccess) { fprintf(stderr, "kernel_launch: cooperative launch %d failed: %s (grid %d)\n", li, hipGetErrorString(e), grid); break; }
    }
}
```

```cpp
#include <hip/hip_runtime.h>
#include <hip/hip_cooperative_groups.h>
#include <cstdio>
#include <cstdint>
namespace cg = cooperative_groups;
namespace pg8 {
#define PG8_LAS __attribute__((address_space(3)))
typedef unsigned short bf16_t;
typedef short bf16x8 __attribute__((ext_vector_type(8)));
typedef float f32x4 __attribute__((ext_vector_type(4)));
typedef unsigned u32x4 __attribute__((ext_vector_type(4)));
constexpr int BM = 256, BK = 64, HALF = 128, HTB = HALF * BK * 2  , STAGE_BYTES = 8 * HTB, NXCD = 8;

__host__ __device__ __forceinline__ int lds_byte(int r, int c) { const int st = (r >> 4) * 2 + (c >> 5), rr = r & 15, cc = c & 31, ob = rr * 64 + cc * 2; return st * 1024 + (ob ^ (((ob >> 9) & 1) << 5)); }
__host__ __device__ __forceinline__ void stage_rc(int b, int& R, int& C) { const int st = b / 1024, sb = b % 1024, swz = sb ^ (((sb >> 9) & 1) << 5); R = (st >> 1) * 16 + swz / 64; C = (st & 1) * 32 + (swz % 64) / 2; }
__host__ __device__ __forceinline__ int perm32(int rho) { const int n = rho >> 4, i = rho & 15; return 8 * (i >> 2) + 4 * n + (i & 3); }

struct Unit { int pm, pn; };
struct Gemm { const bf16_t* A; const bf16_t* Bt; int M, N, K; };

struct StaticOrder {
    int nM, nN, nwg, G, c, WGM;
    __host__ __device__ void init(int M, int N, int G_, int c_, int wgm_) { nM = M / BM; nN = N / BM; nwg = nM * nN; G = G_; c = c_; WGM = wgm_; }
    __host__ __device__ bool next(int i, Unit& u) const {
        const long L = (long)i * G + c; if (L >= nwg) return false;
        int wgid = (int)L; { const int q = nwg / NXCD, r = nwg % NXCD, xcd = wgid % NXCD, off = wgid / NXCD; wgid = (xcd < r ? xcd * (q + 1) : r * (q + 1) + (xcd - r) * q) + off; }
        const int nig = WGM * nN, gid = wgid / nig, fm = gid * WGM, gsz = (nM - fm) < WGM ? (nM - fm) : WGM;
        u.pm = fm + ((wgid % nig) % gsz); u.pn = (wgid % nig) / gsz; return true;
    }
    __device__ __forceinline__ void a_ready(const Unit&) const {}
    __device__ __forceinline__ void done(const Unit&) const {}
};

__device__ __forceinline__ unsigned cvt_pk_bf16(float lo, float hi) { unsigned r; asm volatile("v_cvt_pk_bf16_f32 %0, %1, %2" : "=v"(r) : "v"(lo), "v"(hi)); return r; }
typedef float f32x2 __attribute__((ext_vector_type(2)));
typedef unsigned u32x2 __attribute__((ext_vector_type(2)));
constexpr float RMS_EPS = 1e-6f;
struct EpiProj {
    static constexpr bool PERM = true, AFTER_DRAIN = false;
    bf16_t* O; int ldc; const float* ssq;
    __device__ __forceinline__ void operator()(const f32x4 (&acc)[2][2][4][2], const Unit& u, int wr, int wc, int fr, int fq) const {
        const int row0 = u.pm * BM + wr * 64 + fr, col0 = u.pn * BM + wc * 32 + 8 * fq;
#pragma unroll
        for (int ai = 0; ai < 2; ++ai)
#pragma unroll
            for (int m = 0; m < 4; ++m) { const int row = row0 + ai * HALF + m * 16; const float rs = __builtin_amdgcn_rsqf(ssq[row] * (1.0f / 1024.0f) + RMS_EPS);
                bf16_t* rowp = O + (size_t)row * ldc + col0;
#pragma unroll
                for (int bj = 0; bj < 2; ++bj) { const f32x4 v0 = acc[ai][bj][m][0] * rs, v1 = acc[ai][bj][m][1] * rs;
                    u32x4 w; w.x = cvt_pk_bf16(v0[0], v0[1]); w.y = cvt_pk_bf16(v0[2], v0[3]); w.z = cvt_pk_bf16(v1[0], v1[1]); w.w = cvt_pk_bf16(v1[2], v1[3]);
                    *(u32x4*)(rowp + bj * HALF) = w; } }
    }
};
struct EpiSwiglu {
    static constexpr bool PERM = true, AFTER_DRAIN = false;
    bf16_t* O; int ldc; const float* ssq;
    __device__ __forceinline__ void operator()(const f32x4 (&acc)[2][2][4][2], const Unit& u, int wr, int wc, int fr, int fq) const {
        const int row0 = u.pm * BM + wr * 64 + fr, col0 = u.pn * HALF + wc * 32 + 8 * fq;
#pragma unroll
        for (int ai = 0; ai < 2; ++ai)
#pragma unroll
            for (int m = 0; m < 4; ++m) { const int row = row0 + ai * HALF + m * 16; const float rs = __builtin_amdgcn_rsqf(ssq[row] * (1.0f / 1024.0f) + RMS_EPS);
                float hv[8];
#pragma unroll
                for (int n = 0; n < 2; ++n)
#pragma unroll
                    for (int j = 0; j < 4; ++j) { const float g = acc[ai][0][m][n][j] * rs, up = acc[ai][1][m][n][j] * rs;
                        const float sg = g * __builtin_amdgcn_rcpf(1.0f + __builtin_amdgcn_exp2f(-1.4426950408889634f * g)); hv[n * 4 + j] = sg * up; }
                u32x4 w; w.x = cvt_pk_bf16(hv[0], hv[1]); w.y = cvt_pk_bf16(hv[2], hv[3]); w.z = cvt_pk_bf16(hv[4], hv[5]); w.w = cvt_pk_bf16(hv[6], hv[7]);
                *(u32x4*)(O + (size_t)row * ldc + col0) = w; }
    }
};
struct EpiRes {
    static constexpr bool PERM = true, AFTER_DRAIN = false;
    bf16_t* xb; float* out; float* ssq;
    __device__ __forceinline__ void operator()(const f32x4 (&acc)[2][2][4][2], const Unit& u, int wr, int wc, int fr, int fq) const {
        const int row0 = u.pm * BM + wr * 64 + fr, col0 = u.pn * BM + wc * 32 + 8 * fq;
#pragma unroll
        for (int ai = 0; ai < 2; ++ai)
#pragma unroll
            for (int m = 0; m < 4; ++m) { const int row = row0 + ai * HALF + m * 16; const size_t off = (size_t)row * 1024 + col0; float part = 0.f;
#pragma unroll
                for (int bj = 0; bj < 2; ++bj) { const size_t o = off + bj * HALF; const u32x4 rb = *(const u32x4*)(xb + o);
                    f32x4 v0, v1;
                    v0[0] = __uint_as_float(rb.x << 16) + acc[ai][bj][m][0][0]; v0[1] = __uint_as_float(rb.x & 0xffff0000u) + acc[ai][bj][m][0][1];
                    v0[2] = __uint_as_float(rb.y << 16) + acc[ai][bj][m][0][2]; v0[3] = __uint_as_float(rb.y & 0xffff0000u) + acc[ai][bj][m][0][3];
                    v1[0] = __uint_as_float(rb.z << 16) + acc[ai][bj][m][1][0]; v1[1] = __uint_as_float(rb.z & 0xffff0000u) + acc[ai][bj][m][1][1];
                    v1[2] = __uint_as_float(rb.w << 16) + acc[ai][bj][m][1][2]; v1[3] = __uint_as_float(rb.w & 0xffff0000u) + acc[ai][bj][m][1][3];
                    if (out) { *(f32x4*)(out + o) = v0; *(f32x4*)(out + o + 4) = v1; }
                    else { part += ((v0[0] * v0[0] + v0[1] * v0[1]) + (v0[2] * v0[2] + v0[3] * v0[3])) + ((v1[0] * v1[0] + v1[1] * v1[1]) + (v1[2] * v1[2] + v1[3] * v1[3]));
                        u32x4 w; w.x = cvt_pk_bf16(v0[0], v0[1]); w.y = cvt_pk_bf16(v0[2], v0[3]); w.z = cvt_pk_bf16(v1[0], v1[1]); w.w = cvt_pk_bf16(v1[2], v1[3]); *(u32x4*)(xb + o) = w; } }
                if (!out) { part += __shfl_xor(part, 16); part += __shfl_xor(part, 32);
                    if (fq == 0) __hip_atomic_fetch_add(ssq + row, part, __ATOMIC_RELAXED, __HIP_MEMORY_SCOPE_AGENT); } }
    }
};
template <class Epi, class Sched, bool ALIGN_EPI = false, bool SP2 = false>
__device__ __forceinline__ void gemm_phase(PG8_LAS unsigned char* lds, const Gemm g, const Sched& S, const Epi& E, const int tid_in) {
    const int tid = tid_in, wid = __builtin_amdgcn_readfirstlane(tid >> 6), lane = tid & 63, wr = wid >> 2, wc = wid & 3, fr = lane & 15, fq = lane >> 4;
    const int K = g.K, nt = K / BK;
    unsigned voffA[2], voffB[2];
#pragma unroll
    for (int i = 0; i < 2; ++i) { int R, C; stage_rc(tid * 16 + i * 8192, R, C); const int Rb = Epi::PERM ? ((R & ~31) + perm32(R & 31)) : R;
        voffA[i] = (unsigned)(R * K + C) * 2u; voffB[i] = (unsigned)(Rb * K + C) * 2u; }
    const size_t kstep = (size_t)(BK * 2);
    const size_t hstep = (size_t)HALF * K * 2;
    const size_t tstep = 2 * hstep;
    const unsigned ldsw = (unsigned)wid * 1024u;
    const int aoff = lds_byte(wr * 64 + fr, fq * 8), boff = lds_byte(wc * 32 + fr, fq * 8);
#define PG8_SA(b, h) (((b) * 2 + (h)) * HTB)
#define PG8_SB(b, h) ((4 + (b) * 2 + (h)) * HTB)
#define PG8_STAGE(bufoff, gbase, voff) do { _Pragma("unroll") for (int _i = 0; _i < 2; ++_i) \
        __builtin_amdgcn_global_load_lds((const unsigned*)((const char*)(gbase) + (voff)[_i]), (PG8_LAS unsigned*)(lds + (bufoff) + ldsw + _i * 8192), 16, 0, 0); } while (0)
#define PG8_LDA(dst, b, h) do { _Pragma("unroll") for (int m = 0; m < 4; ++m) _Pragma("unroll") for (int k = 0; k < 2; ++k) dst[m][k] = *(const PG8_LAS bf16x8*)(lds + PG8_SA(b, h) + aoff + m * 2048 + k * 1024); } while (0)
#define PG8_LDB(dst, b, h) do { _Pragma("unroll") for (int n = 0; n < 2; ++n) _Pragma("unroll") for (int k = 0; k < 2; ++k) dst[n][k] = *(const PG8_LAS bf16x8*)(lds + PG8_SB(b, h) + boff + n * 2048 + k * 1024); } while (0)
#define PG8_MMA(ai, bj, At, Bt) do { __builtin_amdgcn_s_setprio(1); _Pragma("unroll") for (int m = 0; m < 4; ++m) _Pragma("unroll") for (int n = 0; n < 2; ++n) _Pragma("unroll") for (int k = 0; k < 2; ++k) \
        acc[ai][bj][m][n] = __builtin_amdgcn_mfma_f32_16x16x32_bf16(Bt[n][k], At[m][k], acc[ai][bj][m][n], 0, 0, 0); __builtin_amdgcn_s_setprio(0); } while (0)
#define PG8_WAIT_V(n) asm volatile("s_waitcnt vmcnt(" #n ")" ::: "memory")
#define PG8_WAIT_L(n) asm volatile("s_waitcnt lgkmcnt(" #n ")" ::: "memory")
#define PG8_BAR __builtin_amdgcn_s_barrier()
#define PG8_SCHED __builtin_amdgcn_sched_barrier(0)
    Unit cur, nxt; int ui = 0;
    if (!S.next(0, cur)) return;
    f32x4 acc[2][2][4][2];
#pragma unroll
    for (int a = 0; a < 2; ++a)
#pragma unroll
        for (int b = 0; b < 2; ++b)
#pragma unroll
            for (int m = 0; m < 4; ++m)
#pragma unroll
                for (int n = 0; n < 2; ++n) acc[a][b][m][n] = (f32x4){0.f, 0.f, 0.f, 0.f};
    bf16x8 At[4][2], B0[2][2], B1[2][2];
    const char* cA = (const char*)g.A + (size_t)cur.pm * tstep; const char* cB = (const char*)g.Bt + (size_t)cur.pn * tstep;
    S.a_ready(cur);
    if constexpr (SP2) {
        PG8_STAGE(PG8_SB(0, 0), cB, voffB); PG8_STAGE(PG8_SB(0, 1), cB + hstep, voffB); PG8_STAGE(PG8_SA(0, 0), cA, voffA); PG8_STAGE(PG8_SA(0, 1), cA + hstep, voffA);
        if (wr == 1) PG8_BAR;
        PG8_WAIT_V(2); PG8_BAR;
        PG8_STAGE(PG8_SB(1, 0), cB + kstep, voffB); PG8_STAGE(PG8_SA(1, 0), cA + kstep, voffA); PG8_STAGE(PG8_SB(1, 1), cB + hstep + kstep, voffB);
        PG8_WAIT_V(6); PG8_BAR;
    } else {
        PG8_STAGE(PG8_SB(0, 0), cB, voffB); PG8_STAGE(PG8_SA(0, 0), cA, voffA); PG8_STAGE(PG8_SB(0, 1), cB + hstep, voffB); PG8_STAGE(PG8_SA(0, 1), cA + hstep, voffA);
        if (wr == 1) PG8_BAR;
        PG8_WAIT_V(4); PG8_BAR;
        PG8_STAGE(PG8_SB(1, 0), cB + kstep, voffB); PG8_STAGE(PG8_SA(1, 0), cA + kstep, voffA); PG8_STAGE(PG8_SB(1, 1), cB + hstep + kstep, voffB);
        PG8_WAIT_V(6); PG8_BAR;
    }
    for (;;) {
        const bool has_next = S.next(ui + 1, nxt);
        const char* nA = has_next ? (const char*)g.A + (size_t)nxt.pm * tstep : cA; const char* nB = has_next ? (const char*)g.Bt + (size_t)nxt.pn * tstep : cB;
        for (int t = 0; t < nt; t += 2) {
            const bool last = (t == nt - 2);
            const char* a1 = cA + (size_t)(t + 1) * kstep;
            const char* a2 = last ? nA : cA + (size_t)(t + 2) * kstep; const char* b2 = last ? nB : cB + (size_t)(t + 2) * kstep;
            const char* a3 = a2 + kstep; const char* b3 = b2 + kstep;
            if (last && has_next) S.a_ready(nxt);
            if constexpr (SP2) {
            PG8_LDB(B0, 0, 0); PG8_LDB(B1, 0, 1); PG8_SCHED; PG8_LDA(At, 0, 0); PG8_STAGE(PG8_SA(1, 1), a1 + hstep, voffA);
            PG8_WAIT_V(8); PG8_WAIT_L(0); PG8_BAR; PG8_MMA(0, 0, At, B0); PG8_MMA(0, 1, At, B1); PG8_BAR; PG8_SCHED;
            PG8_LDA(At, 0, 1); PG8_STAGE(PG8_SB(0, 0), b2, voffB); PG8_STAGE(PG8_SB(0, 1), b2 + hstep, voffB); PG8_STAGE(PG8_SA(0, 0), a2, voffA);
            PG8_WAIT_V(8); PG8_WAIT_L(0); PG8_BAR; PG8_MMA(1, 0, At, B0); PG8_MMA(1, 1, At, B1); PG8_BAR; PG8_SCHED;
            PG8_LDB(B0, 1, 0); PG8_LDB(B1, 1, 1); PG8_SCHED; PG8_LDA(At, 1, 0); PG8_STAGE(PG8_SA(0, 1), a2 + hstep, voffA);
            PG8_WAIT_V(8); PG8_WAIT_L(0); PG8_BAR; PG8_MMA(0, 0, At, B0); PG8_MMA(0, 1, At, B1); PG8_BAR; PG8_SCHED;
            PG8_LDA(At, 1, 1); PG8_STAGE(PG8_SB(1, 0), b3, voffB); PG8_STAGE(PG8_SB(1, 1), b3 + hstep, voffB); PG8_STAGE(PG8_SA(1, 0), a3, voffA);
            PG8_WAIT_V(8); PG8_WAIT_L(0); PG8_BAR; PG8_MMA(1, 0, At, B0); PG8_MMA(1, 1, At, B1); PG8_BAR; PG8_SCHED;
            } else {
            PG8_LDB(B0, 0, 0); PG8_SCHED; PG8_LDA(At, 0, 0); PG8_STAGE(PG8_SA(1, 1), a1 + hstep, voffA);
            PG8_WAIT_L(8); PG8_BAR; PG8_WAIT_L(0); PG8_MMA(0, 0, At, B0); PG8_BAR; PG8_SCHED;
            PG8_LDB(B1, 0, 1); PG8_STAGE(PG8_SB(0, 0), b2, voffB);
            PG8_BAR; PG8_WAIT_L(0); PG8_MMA(0, 1, At, B1); PG8_BAR;
            PG8_LDA(At, 0, 1); PG8_STAGE(PG8_SA(0, 0), a2, voffA);
            PG8_BAR; PG8_WAIT_L(0); PG8_MMA(1, 0, At, B0); PG8_BAR; PG8_SCHED;
            PG8_STAGE(PG8_SB(0, 1), b2 + hstep, voffB);
            PG8_WAIT_V(6); PG8_BAR; PG8_MMA(1, 1, At, B1); PG8_BAR;
            PG8_LDB(B0, 1, 0); PG8_SCHED; PG8_LDA(At, 1, 0); PG8_STAGE(PG8_SA(0, 1), a2 + hstep, voffA);
            PG8_WAIT_L(8); PG8_BAR; PG8_WAIT_L(0); PG8_MMA(0, 0, At, B0); PG8_BAR; PG8_SCHED;
            PG8_LDB(B1, 1, 1); PG8_STAGE(PG8_SB(1, 0), b3, voffB);
            PG8_BAR; PG8_WAIT_L(0); PG8_MMA(0, 1, At, B1); PG8_BAR;
            PG8_LDA(At, 1, 1); PG8_STAGE(PG8_SA(1, 0), a3, voffA);
            PG8_BAR; PG8_WAIT_L(0); PG8_MMA(1, 0, At, B0); PG8_BAR; PG8_SCHED;
            PG8_STAGE(PG8_SB(1, 1), b3 + hstep, voffB);
            PG8_WAIT_V(6); PG8_BAR; PG8_MMA(1, 1, At, B1); PG8_BAR;
            }
        }
        if constexpr (ALIGN_EPI) { if (wr == 0) PG8_BAR; }
        if constexpr (!Epi::AFTER_DRAIN) { E(acc, cur, wr, wc, fr, fq); S.done(cur); }
        if (!has_next) break;
#pragma unroll
        for (int a = 0; a < 2; ++a)
#pragma unroll
            for (int b = 0; b < 2; ++b)
#pragma unroll
                for (int m = 0; m < 4; ++m)
#pragma unroll
                    for (int n = 0; n < 2; ++n) acc[a][b][m][n] = (f32x4){0.f, 0.f, 0.f, 0.f};
        cur = nxt; cA = nA; cB = nB; ++ui;
        if constexpr (ALIGN_EPI) { if (wr == 1) PG8_BAR; }
    }
    PG8_WAIT_V(0);
    if constexpr (!ALIGN_EPI) { if (wr == 0) PG8_BAR; }
    PG8_BAR;
    if constexpr (Epi::AFTER_DRAIN) { E.fused(acc, cur, wr, wc, fr, fq, lds, wid, lane); S.done(cur); }
#undef PG8_SA
#undef PG8_SB
#undef PG8_STAGE
#undef PG8_LDA
#undef PG8_LDB
#undef PG8_MMA
#undef PG8_WAIT_V
#undef PG8_WAIT_L
#undef PG8_BAR
#undef PG8_SCHED
}
}

constexpr int BATCH = 2, SEQ = 8192, DM = 1024, DEPTH = 2;
constexpr int M = BATCH * SEQ;
constexpr int NPROJ = 3584, FF = 2816, NGU = 2 * FF;
constexpr int RH = 8, CH = 128, NCH = SEQ / CH;
constexpr int C_RQ = 0, C_RK = 512, C_RV = 1024, C_RG = 1536, C_DQ = 2048, C_DK = 2560, C_DV = 3072;
constexpr float EPS = 1e-6f, LOG2E = 1.4426950408889634f;
constexpr size_t MiB = 1u << 20;
constexpr size_t WS_CTL = 0, CTL_BYTES = 1 * MiB;
constexpr size_t WS_WIN = 1 * MiB, WS_WOUT = 15 * MiB, WS_WGU = 19 * MiB, WS_WDN = 41 * MiB;
constexpr size_t WS_XB = 52 * MiB;
constexpr size_t WS_MIX = 84 * MiB, WS_PROJ = 116 * MiB, WS_HID = 116 * MiB, WS_RF = 228 * MiB, WS_RB = 236 * MiB, WS_END = 244 * MiB;
constexpr size_t PAR_OFF = 512 * 1024, BAR_OFF = 768 * 1024;
constexpr int LDS_MISC = 131072;
constexpr int LDS_BYTES = 135168;
constexpr int NWAVES = 8;
#ifndef WGM_IN
#define WGM_IN 4
#endif
#ifndef WGM_GU
#define WGM_GU 4
#endif
#ifndef WGM_SQ
#define WGM_SQ 8
#endif

#define LAS __attribute__((address_space(3)))
typedef unsigned short bf16;
typedef short bf16x8 __attribute__((ext_vector_type(8)));
typedef short s16x4 __attribute__((ext_vector_type(4)));
typedef short v4i16_t __attribute__((ext_vector_type(4)));
typedef float f32x4 __attribute__((ext_vector_type(4)));
typedef float f32x16 __attribute__((ext_vector_type(16)));
typedef unsigned u32x4 __attribute__((ext_vector_type(4)));
typedef float f32x2_t __attribute__((ext_vector_type(2)));
typedef __bf16 bf16x2_t __attribute__((ext_vector_type(2)));

__device__ __forceinline__ unsigned pk2(float lo, float hi) { f32x2_t v = {lo, hi}; bf16x2_t b = __builtin_convertvector(v, bf16x2_t); return __builtin_bit_cast(unsigned, b); }
__device__ __forceinline__ float bf2f(unsigned short b) { return __uint_as_float((unsigned)b << 16); }
__device__ __forceinline__ float bflo(unsigned w) { return __uint_as_float(w << 16); }
__device__ __forceinline__ float bfhi(unsigned w) { return __uint_as_float(w & 0xffff0000u); }
__device__ __forceinline__ int crow(int r, int hi) { return (r & 3) + 8 * (r >> 2) + 4 * hi; }
__device__ __forceinline__ s16x4 vtr(const LAS unsigned char* p) { return __builtin_bit_cast(s16x4, __builtin_amdgcn_ds_read_tr16_b64_v4i16((LAS v4i16_t*)p)); }
__device__ __forceinline__ bf16x8 cat8(s16x4 lo, s16x4 hi) { return (bf16x8){lo[0], lo[1], lo[2], lo[3], hi[0], hi[1], hi[2], hi[3]}; }
__device__ __forceinline__ void glds16(const void* g, LAS unsigned char* l) { __builtin_amdgcn_global_load_lds((const unsigned*)g, (LAS unsigned*)l, 16, 0, 0); }
__device__ __forceinline__ void glds16a(const void* g, unsigned lds_dst) { unsigned keep; asm volatile("s_mov_b32 %0, m0\n\ts_mov_b32 m0, %2\n\ts_nop 0\n\tglobal_load_lds_dwordx4 %1, off\n\ts_mov_b32 m0, %0" : "=&s"(keep) : "v"(g), "s"(lds_dst) : "memory"); }
#define MFMA32(a, b, c) __builtin_amdgcn_mfma_f32_32x32x16_bf16((a), (b), (c), 0, 0, 0)
#define VMWAIT0() asm volatile("s_waitcnt vmcnt(0)" ::: "memory")
__device__ __forceinline__ float wave_sum(float v) {
#pragma unroll
    for (int o = 1; o < 64; o <<= 1) v += __shfl_xor(v, o);
    return v;
}
__device__ __forceinline__ float half_sum32(float v) {
#pragma unroll
    for (int o = 1; o < 32; o <<= 1) v += __shfl_xor(v, o);
    return v;
}

struct Params { float lam[DEPTH]; float b2[DEPTH]; };

__device__ __forceinline__ void transpose_item(const float* W, int K, int N, bf16* WT, const float* gk, int rowmap, LAS float* scr, int item, int lane) {
    const int nblk = N / 32, kb = item / nblk, nb = item % nblk, k0 = 64 * kb, n0 = 32 * nb;
#pragma unroll 8
    for (int i = 0; i < 32; ++i) { const int kk = 2 * i + (lane >> 5); scr[kk * 33 + (lane & 31)] = W[(size_t)(k0 + kk) * N + n0 + (lane & 31)]; }
    asm volatile("s_waitcnt lgkmcnt(0)" ::: "memory");
    const int c = lane & 7;
    float g8[8];
#pragma unroll
    for (int i = 0; i < 8; ++i) g8[i] = gk ? gk[k0 + 8 * c + i] : 1.0f;
    const int r0 = rowmap == 0 ? n0 : ((n0 >> 7) * 256 + (n0 & 127) + (rowmap == 2 ? 128 : 0));
#pragma unroll
    for (int j = 0; j < 4; ++j) { const int n = (lane >> 3) + 8 * j; const LAS float* s = scr + (8 * c) * 33 + n;
        u32x4 o; o.x = pk2(s[0 * 33] * g8[0], s[1 * 33] * g8[1]); o.y = pk2(s[2 * 33] * g8[2], s[3 * 33] * g8[3]); o.z = pk2(s[4 * 33] * g8[4], s[5 * 33] * g8[5]); o.w = pk2(s[6 * 33] * g8[6], s[7 * 33] * g8[7]);
        *(u32x4*)(WT + (size_t)(r0 + n) * K + k0 + 8 * c) = o; }
    asm volatile("s_waitcnt lgkmcnt(0)" ::: "memory");
}
__device__ __forceinline__ void row_to_bf16_ssq(const float* xrow, bf16* orow, float* ssq, int lane) {
    const f32x4* xr = (const f32x4*)xrow + lane;
    f32x4 v[4]; float s = 0.f;
#pragma unroll
    for (int j = 0; j < 4; ++j) { v[j] = xr[64 * j]; s += (v[j].x * v[j].x + v[j].y * v[j].y) + (v[j].z * v[j].z + v[j].w * v[j].w); }
    s = wave_sum(s);
    unsigned long long* o8 = (unsigned long long*)orow + lane;
#pragma unroll
    for (int j = 0; j < 4; ++j) o8[64 * j] = (unsigned long long)pk2(v[j].x, v[j].y) | ((unsigned long long)pk2(v[j].z, v[j].w) << 32);
    if (lane == 0) *ssq = s;
}

struct Args { const float* in[18]; float* out; unsigned char* ws; int ph_lo, ph_hi; };
struct Frame {
    LAS unsigned char* lds;
    float* out; unsigned char* ws;
    int tid, lane, wave, vcu, G;
};

__device__ __forceinline__ void p0_prologue(Frame& F, const Args& A) {
    LAS float* scr = (LAS float*)(F.lds + F.wave * 16384);
    const int gw = F.vcu * NWAVES + F.wave, NGW = F.G * NWAVES;
    constexpr int I_IN = (DM / 64) * (NPROJ / 32), I_OUT = (DM / 64) * (DM / 32), I_G = (DM / 64) * (FF / 32), I_D = (FF / 64) * (DM / 32);
    constexpr int PER_LAYER = I_IN + I_OUT + 2 * I_G + I_D;
    for (int it = gw; it < DEPTH * PER_LAYER; it += NGW) {
        const int l = it / PER_LAYER; int r = it % PER_LAYER;
        const float* g_attn = A.in[1] + l * DM; const float* g_ffn = A.in[14] + l * DM;
        if (r < I_IN) { transpose_item(A.in[2] + (size_t)l * DM * NPROJ, DM, NPROJ, (bf16*)(F.ws + WS_WIN) + (size_t)l * NPROJ * DM, g_attn, 0, scr, r, F.lane); continue; } r -= I_IN;
        if (r < I_OUT) { transpose_item(A.in[13] + (size_t)l * DM * DM, DM, DM, (bf16*)(F.ws + WS_WOUT) + (size_t)l * DM * DM, nullptr, 0, scr, r, F.lane); continue; } r -= I_OUT;
        if (r < I_G) { transpose_item(A.in[15] + (size_t)l * DM * FF, DM, FF, (bf16*)(F.ws + WS_WGU) + (size_t)l * NGU * DM, g_ffn, 1, scr, r, F.lane); continue; } r -= I_G;
        if (r < I_G) { transpose_item(A.in[16] + (size_t)l * DM * FF, DM, FF, (bf16*)(F.ws + WS_WGU) + (size_t)l * NGU * DM, g_ffn, 2, scr, r, F.lane); continue; } r -= I_G;
        transpose_item(A.in[17] + (size_t)l * FF * DM, FF, DM, (bf16*)(F.ws + WS_WDN) + (size_t)l * DM * FF, nullptr, 0, scr, r, F.lane);
    }
    float* ssq0 = (float*)(F.ws + WS_CTL);
    for (int m = gw; m < M; m += NGW) row_to_bf16_ssq(A.in[0] + (size_t)m * DM, (bf16*)(F.ws + WS_XB) + (size_t)m * DM, ssq0 + m, F.lane);
    if (blockIdx.x == 0 && F.wave == 0) {
        Params* P = (Params*)(F.ws + WS_CTL + PAR_OFF);
        for (int l = 0; l < DEPTH; ++l) {
            const float a = wave_sum(A.in[8][l * 64 + F.lane] * A.in[9][l * 64 + F.lane]), b = wave_sum(A.in[10][l * 64 + F.lane] * A.in[11][l * 64 + F.lane]);
            const float lam_init = 0.8f - 0.6f * expf(-0.3f * (float)l);
            if (F.lane == 0) P->lam[l] = expf(a) - expf(b) + lam_init;
            float gq = fabsf(A.in[6][l * 64 + F.lane]), gk = fabsf(A.in[7][l * 64 + F.lane]);
#pragma unroll
            for (int o = 1; o < 64; o <<= 1) { gq = fmaxf(gq, __shfl_xor(gq, o)); gk = fmaxf(gk, __shfl_xor(gk, o)); }
            if (F.lane == 0) P->b2[l] = 8.0f * LOG2E * 1.02f * gq * gk;
        }
    }
}

__device__ __forceinline__ void qknorm_pass(Frame& F, const Args& A, int l) {
    bf16* PROJ = (bf16*)(F.ws + WS_PROJ);
    const int c = F.tid & 127, sub = F.tid >> 7;
    const bool isq = c < 64; const int d0 = (8 * c) & 63;
    const float* g = (isq ? A.in[6] : A.in[7]) + l * 64 + d0; const float sc = isq ? 0.125f * LOG2E : 1.0f;
    float g8[8];
#pragma unroll
    for (int i = 0; i < 8; ++i) g8[i] = g[i] * sc;
    for (int it0 = F.vcu; it0 < M / 4; it0 += 4 * F.G) {
        u32x4 wv[4];
#pragma unroll
        for (int q = 0; q < 4; ++q) { const int it = it0 + q * F.G; if (it < M / 4) wv[q] = *(const u32x4*)(PROJ + (size_t)(4 * it + sub) * NPROJ + C_DQ + 8 * c); }
#pragma unroll
        for (int q = 0; q < 4; ++q) { const int it = it0 + q * F.G; if (it < M / 4) {
            u32x4* p = (u32x4*)(PROJ + (size_t)(4 * it + sub) * NPROJ + C_DQ + 8 * c);
            const u32x4 w = wv[q]; float x[8] = {bflo(w.x), bfhi(w.x), bflo(w.y), bfhi(w.y), bflo(w.z), bfhi(w.z), bflo(w.w), bfhi(w.w)};
            float ss = 0.f;
#pragma unroll
            for (int i = 0; i < 8; ++i) ss += x[i] * x[i];
            ss += __shfl_xor(ss, 1); ss += __shfl_xor(ss, 2); ss += __shfl_xor(ss, 4);
            const float r = __builtin_amdgcn_rsqf(ss * (1.0f / 64.0f) + EPS);
            u32x4 o; o.x = pk2(x[0] * r * g8[0], x[1] * r * g8[1]); o.y = pk2(x[2] * r * g8[2], x[3] * r * g8[3]); o.z = pk2(x[4] * r * g8[4], x[5] * r * g8[5]); o.w = pk2(x[6] * r * g8[6], x[7] * r * g8[7]);
            *p = o; } }
    }
}
__device__ __forceinline__ int tr_off128(int lane, int r0, int cb) { return (r0 + ((lane & 15) >> 2)) * 128 + (32 * cb + 16 * ((lane >> 4) & 1)) * 2 + 8 * (lane & 3); }

__device__ __forceinline__ void ret_kv_item(Frame& F, const Args& A, int l, int item) {
    const bf16* PROJ = (const bf16*)(F.ws + WS_PROJ);
    const int n = item & 63, h = (item >> 6) & 7, b = item >> 9;
    int lane_ = F.lane; asm volatile("" : "+v"(lane_));
    const int tid_ = (F.wave << 6) | lane_;
    const float lgf2 = -expf(A.in[3][l * RH + h]) * LOG2E, lgb2 = -expf(A.in[4][l * RH + h]) * LOG2E;
    const size_t row0 = (size_t)b * SEQ + (size_t)n * CH;
    LAS unsigned char* LK = F.lds; LAS unsigned char* LVF = F.lds + 16384; LAS unsigned char* LVB = F.lds + 32768;
#pragma unroll
    for (int i = 0; i < 2; ++i) { const int pc = tid_ + 512 * i, s = pc >> 3, ch = pc & 7;
        const u32x4 kw = *(const u32x4*)(PROJ + (row0 + s) * NPROJ + C_RK + h * 64 + 8 * ch);
        const u32x4 vw = *(const u32x4*)(PROJ + (row0 + s) * NPROJ + C_RV + h * 64 + 8 * ch);
        *(LAS u32x4*)(LK + s * 128 + ch * 16) = kw;
        const float wf = __builtin_amdgcn_exp2f(lgf2 * (float)(CH - 1 - s)) * 0.125f, wb = __builtin_amdgcn_exp2f(lgb2 * (float)s) * 0.125f;
        const float x[8] = {bflo(vw.x), bfhi(vw.x), bflo(vw.y), bfhi(vw.y), bflo(vw.z), bfhi(vw.z), bflo(vw.w), bfhi(vw.w)};
        u32x4 a, c2;
        a.x = pk2(x[0] * wf, x[1] * wf); a.y = pk2(x[2] * wf, x[3] * wf); a.z = pk2(x[4] * wf, x[5] * wf); a.w = pk2(x[6] * wf, x[7] * wf);
        c2.x = pk2(x[0] * wb, x[1] * wb); c2.y = pk2(x[2] * wb, x[3] * wb); c2.z = pk2(x[4] * wb, x[5] * wb); c2.w = pk2(x[6] * wb, x[7] * wb);
        *(LAS u32x4*)(LVF + s * 128 + ch * 16) = a; *(LAS u32x4*)(LVB + s * 128 + ch * 16) = c2; }
    __syncthreads();
    const int dir = F.wave >> 2, db = (F.wave >> 1) & 1, eb = F.wave & 1, hi = lane_ >> 5;
    const LAS unsigned char* LV = dir ? LVB : LVF;
    const int tb8 = (8 * hi + ((lane_ & 15) >> 2)) * 128 + 32 * ((lane_ >> 4) & 1) + 8 * (lane_ & 3);
    const LAS unsigned char* pa = LK + tb8 + 64 * db; const LAS unsigned char* pb_ = LV + tb8 + 64 * eb;
    f32x16 acc = {};
#pragma unroll
    for (int st = 0; st < 8; ++st) {
        const bf16x8 a = cat8(vtr(pa + st * 2048), vtr(pa + st * 2048 + 512));
        const bf16x8 bb = cat8(vtr(pb_ + st * 2048), vtr(pb_ + st * 2048 + 512));
        acc = MFMA32(a, bb, acc);
    }
    float* KV = (float*)((unsigned char*)F.out + (dir ? 16 * MiB : 0)) + (size_t)item * 4096;
#pragma unroll
    for (int r = 0; r < 16; ++r) KV[(32 * db + crow(r, hi)) * 64 + 32 * eb + (lane_ & 31)] = acc[r];
    __syncthreads();
}

__device__ __forceinline__ void ret_scan(Frame& F, const Args& A, int l) {
    const int total = 2 * BATCH * RH * 4096;
    for (int gid = F.vcu * 512 + F.tid; gid < total; gid += F.G * 512) {
        const int dir = gid / (BATCH * RH * 4096), rem = gid % (BATCH * RH * 4096), bh = rem >> 12, el = rem & 4095, h = bh & 7;
        const float lg = -expf((dir ? A.in[4] : A.in[3])[l * RH + h]); const float dc = expf(lg * (float)CH);
        const float* KV = (const float*)((unsigned char*)F.out + (dir ? 16 * MiB : 0)) + (size_t)bh * NCH * 4096 + el;
        bf16* R = (bf16*)(F.ws + (dir ? WS_RB : WS_RF)) + (size_t)bh * NCH * 4096 + el;
        float st = 0.f;
#pragma unroll 1
        for (int blk = 0; blk < NCH / 32; ++blk) {
            float kv[32];
            if (dir == 0) {
#pragma unroll
                for (int j = 0; j < 32; ++j) kv[j] = KV[(size_t)(blk * 32 + j) * 4096];
#pragma unroll
                for (int j = 0; j < 32; ++j) { R[(size_t)(blk * 32 + j) * 4096] = (bf16)(pk2(st, 0.f) & 0xffffu); st = dc * st + kv[j]; }
            } else {
#pragma unroll
                for (int j = 0; j < 32; ++j) kv[j] = KV[(size_t)(NCH - 1 - blk * 32 - j) * 4096];
#pragma unroll
                for (int j = 0; j < 32; ++j) { R[(size_t)(NCH - 1 - blk * 32 - j) * 4096] = (bf16)(pk2(st, 0.f) & 0xffffu); st = dc * st + kv[j]; }
            }
        }
    }
}

__device__ __forceinline__ void attn_half(Frame& F, const Args& A, int l, int b, int h, int qb, int m) {
    const bf16* PROJ = (const bf16*)(F.ws + WS_PROJ); bf16* OB = (bf16*)((unsigned char*)F.out + 32 * MiB) + (size_t)m * M * 512;
    int lane = F.lane; asm volatile("" : "+v"(lane));
    const int r32 = lane & 31, hi = lane >> 5, wid = F.wave;
    const size_t rowbase = (size_t)b * SEQ; const int q0 = qb * 256 + wid * 32;
    const float B2 = ((const Params*)(F.ws + WS_CTL + PAR_OFF))->b2[l];
    const float slope2 = exp2f(-2.0f * (float)(h + 1)) * LOG2E, nslope2 = -slope2;
    const int dthr = (int)(150.0f / slope2) + 1;
    const int t_lo = max(0, ((qb * 256 - 63 - dthr) >> 6) + 1), t_hi = min(SEQ / 64, (qb * 256 + 255 + dthr + 63) >> 6);
    LAS unsigned char* lds = F.lds;
    LAS float* wsf = (LAS float*)(lds + 73728) + wid * 64;
    const bf16* kvb = PROJ + rowbase * NPROJ;
    const bf16* vsrc = kvb + (size_t)(16 * (wid & 3) + (lane >> 2)) * NPROJ + C_DV + h * 128 + 32 * (wid >> 2) + 8 * (lane & 3);
    const int vlane = ((lane >> 4) & 1) * 32 + (lane & 3) * 8 + (4 * hi + ((lane & 15) >> 2)) * 64;
    const int klane = (r32 >> 3) * 1024 + (r32 & 7) * 128 + ((hi ^ (r32 & 7)) << 4);
    bf16x8 qf[4];
    { const bf16* qrow = PROJ + (rowbase + q0 + r32) * NPROJ + C_DQ + h * 128 + m * 64 + hi * 8;
#pragma unroll
      for (int d0 = 0; d0 < 4; ++d0) qf[d0] = *(const bf16x8*)(qrow + d0 * 16); }
    const bf16* ksrc = kvb + (size_t)(8 * wid + (lane >> 3)) * NPROJ + C_DK + h * 128 + m * 64 + 8 * ((lane & 7) ^ (lane >> 3));
    f32x16 oa[4];
#pragma unroll
    for (int i = 0; i < 4; ++i) oa[i] = f32x16{};
    float ls = 0.f;
    const int n = t_hi - t_lo;
    const int tq = q0 >> 6;
    const unsigned ldsb = (unsigned)(uintptr_t)lds;
    const float dq0 = (float)(q0 + r32 - t_lo * 64 - 4 * hi);
#define DMA_K(i, slot) glds16a(ksrc + (size_t)min(t_lo + (i), SEQ / 64 - 1) * 64 * NPROJ, (unsigned)__builtin_amdgcn_readfirstlane((int)(ldsb + (slot) * 8192 + wid * 1024)))
#define DMA_V(i, slot) do { const bf16* v_ = vsrc + (size_t)min(t_lo + (i), SEQ / 64 - 1) * 64 * NPROJ; const unsigned d_ = (unsigned)__builtin_amdgcn_readfirstlane((int)(ldsb + 24576 + (slot) * 16384 + wid * 1024)); glds16a(v_, d_); glds16a(v_ + 64, d_ + 8192); } while (0)
#define KADDR(p, d0) ((const LAS unsigned char*)(uintptr_t)((unsigned)(uintptr_t)(p) ^ (unsigned)((d0) << 5)))
#define BIAS(S0, S1, i) do { const float dq_ = dq0 - 64.0f * (float)(i); _Pragma("unroll") for (int r = 0; r < 16; ++r) { const float c = (float)((r & 3) + 8 * (r >> 2)); \
        S0[r] = nslope2 * fabsf(dq_ - c) - B2; S1[r] = nslope2 * fabsf(dq_ - (c + 32.0f)) - B2; } } while (0)
#define QK_ACC(S0, S1, slot) do { const LAS unsigned char* kp_ = lds + (slot) * 8192 + klane; _Pragma("unroll") for (int d0 = 0; d0 < 4; ++d0) { \
        const LAS unsigned char* ka_ = KADDR(kp_, d0); const bf16x8 b0 = *(const LAS bf16x8*)(ka_); const bf16x8 b1 = *(const LAS bf16x8*)(ka_ + 4096); \
        S0 = MFMA32(b0, qf[d0], S0); S1 = MFMA32(b1, qf[d0], S1); } } while (0)
#define FENCE() __builtin_amdgcn_sched_barrier(0)
#define EXP4(C, k, s_) do { C[k] = __builtin_amdgcn_exp2f(C[k]); C[(k) + 1] = __builtin_amdgcn_exp2f(C[(k) + 1]); C[(k) + 2] = __builtin_amdgcn_exp2f(C[(k) + 2]); C[(k) + 3] = __builtin_amdgcn_exp2f(C[(k) + 3]); \
        s_ += (C[k] + C[(k) + 1]) + (C[(k) + 2] + C[(k) + 3]); } while (0)
#define PACK8(C, k) (u32x4){pk2(C[k], C[(k) + 1]), pk2(C[(k) + 2], C[(k) + 3]), pk2(C[(k) + 4], C[(k) + 5]), pk2(C[(k) + 6], C[(k) + 7])}
#define KLD(dst0, dst1, d0) do { const LAS unsigned char* ka_ = KADDR(kp_, d0); dst0 = *(const LAS bf16x8*)(ka_); dst1 = *(const LAS bf16x8*)(ka_ + 4096); } while (0)
#define VLD(dst, off) dst = cat8(vtr(vb_ + (off)), vtr(vb_ + (off) + 512))
#define BIAS4(S0, S1, k, dq_) do { if (strad_) { _Pragma("unroll") for (int r = (k); r < (k) + 4; ++r) { const float c = (float)((r & 3) + 8 * (r >> 2)); \
        S0[r] = nslope2 * fabsf(dq_ - c) - B2; S1[r] = nslope2 * fabsf(dq_ - (c + 32.0f)) - B2; } } \
      else { BIAS4F_##k(S0, S1); } } while (0)
#define FMK(dst, base, K) do { float t_; asm("v_fmamk_f32 %0, %1, " #K ", %2" : "=v"(t_) : "v"(sg_), "v"(base)); dst = t_; } while (0)
#define BIAS4F_0(S0, S1) do { FMK(S0[0], base0_, 0x00000000); FMK(S1[0], base1_, 0x00000000); FMK(S0[1], base0_, 0x3f800000); FMK(S1[1], base1_, 0x3f800000); FMK(S0[2], base0_, 0x40000000); FMK(S1[2], base1_, 0x40000000); FMK(S0[3], base0_, 0x40400000); FMK(S1[3], base1_, 0x40400000); } while (0)
#define BIAS4F_4(S0, S1) do { FMK(S0[4], base0_, 0x41000000); FMK(S1[4], base1_, 0x41000000); FMK(S0[5], base0_, 0x41100000); FMK(S1[5], base1_, 0x41100000); FMK(S0[6], base0_, 0x41200000); FMK(S1[6], base1_, 0x41200000); FMK(S0[7], base0_, 0x41300000); FMK(S1[7], base1_, 0x41300000); } while (0)
#define BIAS4F_8(S0, S1) do { FMK(S0[8], base0_, 0x41800000); FMK(S1[8], base1_, 0x41800000); FMK(S0[9], base0_, 0x41880000); FMK(S1[9], base1_, 0x41880000); FMK(S0[10], base0_, 0x41900000); FMK(S1[10], base1_, 0x41900000); FMK(S0[11], base0_, 0x41980000); FMK(S1[11], base1_, 0x41980000); } while (0)
#define BIAS4F_12(S0, S1) do { FMK(S0[12], base0_, 0x41c00000); FMK(S1[12], base1_, 0x41c00000); FMK(S0[13], base0_, 0x41c80000); FMK(S1[13], base1_, 0x41c80000); FMK(S0[14], base0_, 0x41d00000); FMK(S1[14], base1_, 0x41d00000); FMK(S0[15], base0_, 0x41d80000); FMK(S1[15], base1_, 0x41d80000); } while (0)
#define STEP(C0, C1, N0, N1, i) do { \
        DMA_K((i) + 3, r0); DMA_V((i) + 2, r2);     \
        const LAS unsigned char* kp_ = lds + r1 * 8192 + klane; \
        const LAS unsigned char* vb_ = lds + 24576 + r0 * 16384 + vlane; \
        const float dq2_ = dq0 - 64.0f * (float)((i) + 2); \
        const int tt_ = t_lo + (i) + 2; const bool strad_ = (tt_ == tq); const float sg_ = (tt_ < tq) ? slope2 : nslope2; const float base0_ = -sg_ * dq2_ - B2, base1_ = base0_ + 32.0f * sg_; \
        float s_ = 0.f; bf16x8 ka0, ka1, va, vb2, vc, vd; u32x4 pw0, pw1, pw2, pw3; \
        KLD(ka0, ka1, 0); \
        FENCE(); \
          \
        N0 = MFMA32(ka0, qf[0], N0); N1 = MFMA32(ka1, qf[0], N1); KLD(ka0, ka1, 1); EXP4(C0, 0, s_); FENCE(); \
        N0 = MFMA32(ka0, qf[1], N0); N1 = MFMA32(ka1, qf[1], N1); KLD(ka0, ka1, 2); EXP4(C0, 4, s_); pw0 = PACK8(C0, 0); FENCE(); \
        N0 = MFMA32(ka0, qf[2], N0); N1 = MFMA32(ka1, qf[2], N1); KLD(ka0, ka1, 3); EXP4(C0, 8, s_); FENCE(); \
        N0 = MFMA32(ka0, qf[3], N0); N1 = MFMA32(ka1, qf[3], N1); VLD(va, 0); VLD(vb2, 4096); EXP4(C0, 12, s_); pw1 = PACK8(C0, 8); FENCE(); \
          \
        VLD(vc, 8192); VLD(vd, 12288); oa[0] = MFMA32(__builtin_bit_cast(bf16x8, pw0), va, oa[0]); oa[1] = MFMA32(__builtin_bit_cast(bf16x8, pw0), vb2, oa[1]); EXP4(C1, 0, s_); FENCE(); \
        VLD(va, 1024); VLD(vb2, 5120); oa[2] = MFMA32(__builtin_bit_cast(bf16x8, pw0), vc, oa[2]); oa[3] = MFMA32(__builtin_bit_cast(bf16x8, pw0), vd, oa[3]); EXP4(C1, 4, s_); pw2 = PACK8(C1, 0); FENCE(); \
        VLD(vc, 9216); VLD(vd, 13312); oa[0] = MFMA32(__builtin_bit_cast(bf16x8, pw1), va, oa[0]); oa[1] = MFMA32(__builtin_bit_cast(bf16x8, pw1), vb2, oa[1]); EXP4(C1, 8, s_); FENCE(); \
        VLD(va, 2048); VLD(vb2, 6144); oa[2] = MFMA32(__builtin_bit_cast(bf16x8, pw1), vc, oa[2]); oa[3] = MFMA32(__builtin_bit_cast(bf16x8, pw1), vd, oa[3]); EXP4(C1, 12, s_); pw3 = PACK8(C1, 8); FENCE(); \
        ls += s_; \
        VLD(vc, 10240); VLD(vd, 14336); oa[0] = MFMA32(__builtin_bit_cast(bf16x8, pw2), va, oa[0]); oa[1] = MFMA32(__builtin_bit_cast(bf16x8, pw2), vb2, oa[1]); BIAS4(C0, C1, 0, dq2_); FENCE(); \
        VLD(va, 3072); VLD(vb2, 7168); oa[2] = MFMA32(__builtin_bit_cast(bf16x8, pw2), vc, oa[2]); oa[3] = MFMA32(__builtin_bit_cast(bf16x8, pw2), vd, oa[3]); BIAS4(C0, C1, 4, dq2_); FENCE(); \
        VLD(vc, 11264); VLD(vd, 15360); oa[0] = MFMA32(__builtin_bit_cast(bf16x8, pw3), va, oa[0]); oa[1] = MFMA32(__builtin_bit_cast(bf16x8, pw3), vb2, oa[1]); BIAS4(C0, C1, 8, dq2_); FENCE(); \
        oa[2] = MFMA32(__builtin_bit_cast(bf16x8, pw3), vc, oa[2]); oa[3] = MFMA32(__builtin_bit_cast(bf16x8, pw3), vd, oa[3]); BIAS4(C0, C1, 12, dq2_); FENCE(); \
        asm volatile("s_waitcnt vmcnt(3)" ::: "memory"); \
        __syncthreads(); { const int t_ = r0; r0 = r1; r1 = r2; r2 = t_; } } while (0)
    f32x16 A0, A1, B0, B1;
    if (wid >= 4) __builtin_amdgcn_s_setprio(1);
    int r0 = 0, r1 = 1, r2 = 2;
    DMA_K(0, 0); DMA_V(0, 0); DMA_K(1, 1); DMA_V(1, 1); DMA_K(2, 2);
    BIAS(A0, A1, 0);
    VMWAIT0(); __syncthreads();
    { const LAS unsigned char* kp_ = lds + klane; _Pragma("unroll") for (int d0 = 0; d0 < 4; ++d0) {
        const LAS unsigned char* ka_ = KADDR(kp_, d0); const bf16x8 b0 = *(const LAS bf16x8*)(ka_); const bf16x8 b1 = *(const LAS bf16x8*)(ka_ + 4096);
        A0 = MFMA32(b0, qf[d0], A0); A1 = MFMA32(b1, qf[d0], A1); } }
    BIAS(B0, B1, 1);
    asm volatile("s_waitcnt lgkmcnt(0)" ::: "memory"); __syncthreads();
#pragma unroll 1
    for (int i = 0;; i += 2) {
        STEP(A0, A1, B0, B1, i);
        if (i + 1 >= n) break;
        STEP(B0, B1, A0, A1, i + 1);
        if (i + 2 >= n) break;
    }
    VMWAIT0();
    __builtin_amdgcn_s_setprio(0);
#undef DMA_K
#undef DMA_V
#undef BIAS
#undef QK_ACC
#undef KADDR
#undef STEP
#undef FENCE
#undef EXP4
#undef PACK8
#undef KLD
#undef VLD
#undef BIAS4
    ls += __shfl_xor(ls, 32);
    int le = lane; asm volatile("" : "+v"(le));
    const int r32e = le & 31, hie = le >> 5;
    if (hie == 0) wsf[r32e] = 1.0f / ls;
    asm volatile("s_waitcnt lgkmcnt(0)" ::: "memory");
#pragma unroll
    for (int r = 0; r < 16; ++r) {
        const int qr = crow(r, hie); const float a1 = wsf[qr];
        bf16* orow = OB + (rowbase + q0 + qr) * 512 + h * 128 + r32e;
#pragma unroll
        for (int db = 0; db < 4; ++db) orow[32 * db] = (bf16)(pk2(oa[db][r] * a1, 0.f) & 0xffffu);
        asm volatile("" ::: "memory");
    }
    __syncthreads();
}
__device__ __forceinline__ void attn_combine(Frame& F, const Args& A, int l) {
    const bf16* OB0 = (const bf16*)((unsigned char*)F.out + 32 * MiB); const bf16* OB1 = OB0 + (size_t)M * 512; bf16* MIX = (bf16*)(F.ws + WS_MIX);
    const Params* P = (const Params*)(F.ws + WS_CTL + PAR_OFF);
    const float lam = P->lam[l], post = 1.0f - (0.8f - 0.6f * expf(-0.3f * (float)l));
    const int c16 = F.tid & 15, grp = F.tid >> 4;
    float g8[8];
#pragma unroll
    for (int i = 0; i < 8; ++i) g8[i] = A.in[12][l * 128 + 8 * c16 + i] * post;
    for (int it0 = F.vcu; it0 < M * 4 / 32; it0 += 4 * F.G) {
        u32x4 av[4], bv[4];
#pragma unroll
        for (int q = 0; q < 4; ++q) { const int it = it0 + q * F.G; if (it < M * 4 / 32) { const int gi = it * 32 + grp; const size_t off = (size_t)(gi >> 2) * 512 + (gi & 3) * 128 + 8 * c16;
            av[q] = *(const u32x4*)(OB0 + off); bv[q] = *(const u32x4*)(OB1 + off); } }
#pragma unroll
        for (int q = 0; q < 4; ++q) { const int it = it0 + q * F.G; if (it < M * 4 / 32) {
            const int gi = it * 32 + grp, row = gi >> 2, h = gi & 3;
            const u32x4 a = av[q], bq = bv[q];
            float v[8] = {bflo(a.x) - lam * bflo(bq.x), bfhi(a.x) - lam * bfhi(bq.x), bflo(a.y) - lam * bflo(bq.y), bfhi(a.y) - lam * bfhi(bq.y),
                          bflo(a.z) - lam * bflo(bq.z), bfhi(a.z) - lam * bfhi(bq.z), bflo(a.w) - lam * bflo(bq.w), bfhi(a.w) - lam * bfhi(bq.w)};
            float ss = 0.f;
#pragma unroll
            for (int i = 0; i < 8; ++i) ss += v[i] * v[i];
            ss += __shfl_xor(ss, 1); ss += __shfl_xor(ss, 2); ss += __shfl_xor(ss, 4); ss += __shfl_xor(ss, 8);
            const float rs = __builtin_amdgcn_rsqf(ss * (1.0f / 128.0f) + EPS);
            u32x4 o; o.x = pk2(v[0] * rs * g8[0], v[1] * rs * g8[1]); o.y = pk2(v[2] * rs * g8[2], v[3] * rs * g8[3]); o.z = pk2(v[4] * rs * g8[4], v[5] * rs * g8[5]); o.w = pk2(v[6] * rs * g8[6], v[7] * rs * g8[7]);
            *(u32x4*)(MIX + (size_t)row * DM + 512 + h * 128 + 8 * c16) = o; } }
    }
}

__device__ __forceinline__ void ret_out_pair(Frame& F, const Args& A, int l, int pair) {
    const bf16* PROJ = (const bf16*)(F.ws + WS_PROJ); bf16* MIX = (bf16*)(F.ws + WS_MIX);
    int lane = F.lane; asm volatile("" : "+v"(lane));
    const int r32 = lane & 31, hi = lane >> 5, grp = F.wave >> 2, wq = F.wave & 3, gt = (wq << 6) | lane;
    const int item = 2 * pair + grp; const int n = item & 63, h = (item >> 6) & 7, b = item >> 9;
    const float lgf2 = -expf(A.in[3][l * RH + h]) * LOG2E, lgb2 = -expf(A.in[4][l * RH + h]) * LOG2E;
    const size_t row0 = (size_t)b * SEQ + (size_t)n * CH;
    LAS unsigned char* LK = F.lds + grp * 49152; LAS unsigned char* LV = LK + 16384; LAS unsigned char* LRF = LK + 32768; LAS unsigned char* LRB = LK + 40960;
    const bf16* RF = (const bf16*)(F.ws + WS_RF) + (size_t)item * 4096; const bf16* RB = (const bf16*)(F.ws + WS_RB) + (size_t)item * 4096;
#pragma unroll
    for (int i = 0; i < 4; ++i) { const int pc = gt + 256 * i, s = pc >> 3, ch = pc & 7;
        *(LAS u32x4*)(LV + s * 128 + ch * 16) = *(const u32x4*)(PROJ + (row0 + s) * NPROJ + C_RV + h * 64 + 8 * ch);
        *(LAS u32x4*)(LK + s * 128 + ((ch ^ (s & 7)) << 4)) = *(const u32x4*)(PROJ + (row0 + s) * NPROJ + C_RK + h * 64 + 8 * ch); }
#pragma unroll
    for (int i = 0; i < 2; ++i) { const int pc = gt + 256 * i;
        *(LAS u32x4*)(LRF + pc * 16) = *(const u32x4*)(RF + pc * 8); *(LAS u32x4*)(LRB + pc * 16) = *(const u32x4*)(RB + pc * 8); }
    const int t0 = 32 * wq;
    LAS unsigned char* GW = F.lds + 98304 + F.wave * 4096;
#pragma unroll
    for (int i = 0; i < 4; ++i) { const int pc = lane + 64 * i, rw = pc >> 3, ch = pc & 7;
        *(LAS u32x4*)(GW + rw * 128 + ch * 16) = *(const u32x4*)(PROJ + (row0 + t0 + rw) * NPROJ + C_RG + h * 64 + 8 * ch); }
    bf16x8 qf[4];
    { const bf16* qrow = PROJ + (row0 + t0 + r32) * NPROJ + C_RQ + h * 64 + hi * 8;
#pragma unroll
      for (int d0 = 0; d0 < 4; ++d0) qf[d0] = *(const bf16x8*)(qrow + d0 * 16); }
    __syncthreads();
    f32x16 X[4];
    const unsigned kb0 = (unsigned)(uintptr_t)LK + (unsigned)(r32 * 128 + ((hi ^ (r32 & 7)) << 4));
#pragma unroll
    for (int sb = 0; sb < 4; ++sb) { X[sb] = f32x16{};
#pragma unroll
        for (int d0 = 0; d0 < 4; ++d0) { const bf16x8 kf = *(const LAS bf16x8*)(uintptr_t)((kb0 + sb * 4096) ^ (unsigned)(d0 << 5)); X[sb] = MFMA32(kf, qf[d0], X[sb]); } }
    u32x4 pw[8];
    const float tf = (float)(t0 + r32);
#pragma unroll
    for (int sb = 0; sb < 4; ++sb) {
#pragma unroll
        for (int r = 0; r < 16; ++r) { const float dl = tf - (float)(32 * sb + crow(r, hi)); const float e = lgf2 * fmaxf(dl, 0.f) + lgb2 * fmaxf(-dl, 0.f); X[sb][r] *= __builtin_amdgcn_exp2f(e - 3.0f); }
        pw[2 * sb] = (u32x4){pk2(X[sb][0], X[sb][1]), pk2(X[sb][2], X[sb][3]), pk2(X[sb][4], X[sb][5]), pk2(X[sb][6], X[sb][7])};
        pw[2 * sb + 1] = (u32x4){pk2(X[sb][8], X[sb][9]), pk2(X[sb][10], X[sb][11]), pk2(X[sb][12], X[sb][13]), pk2(X[sb][14], X[sb][15])};
    }
    __builtin_amdgcn_sched_barrier(0);
    const int q4 = (lane & 15) >> 2, tcol = 32 * ((lane >> 4) & 1) + 8 * (lane & 3);
    const LAS unsigned char* pv = LV + (4 * hi + q4) * 128 + tcol;
    const LAS unsigned char* prf = LRF + (8 * hi + q4) * 128 + tcol;
    const LAS unsigned char* prb = LRB + (8 * hi + q4) * 128 + tcol;
    f32x16 aI[2], aF[2], aB[2];
#pragma unroll
    for (int eb = 0; eb < 2; ++eb) { aI[eb] = f32x16{};
#pragma unroll
        for (int ks = 0; ks < 8; ++ks) {
            const bf16x8 vf = cat8(vtr(pv + ks * 2048 + 64 * eb), vtr(pv + ks * 2048 + 1024 + 64 * eb));
            aI[eb] = MFMA32(__builtin_bit_cast(bf16x8, pw[ks]), vf, aI[eb]); } }
    __builtin_amdgcn_sched_barrier(0);
#pragma unroll
    for (int eb = 0; eb < 2; ++eb) { aF[eb] = f32x16{}; aB[eb] = f32x16{};
#pragma unroll
        for (int d0 = 0; d0 < 4; ++d0) {
            const bf16x8 rf = cat8(vtr(prf + d0 * 2048 + 64 * eb), vtr(prf + d0 * 2048 + 512 + 64 * eb));
            const bf16x8 rb = cat8(vtr(prb + d0 * 2048 + 64 * eb), vtr(prb + d0 * 2048 + 512 + 64 * eb));
            aF[eb] = MFMA32(qf[d0], rf, aF[eb]); aB[eb] = MFMA32(qf[d0], rb, aB[eb]); } }
    __builtin_amdgcn_sched_barrier(0);
    const float* rng = A.in[5] + l * 64; const float g0 = rng[r32], g1 = rng[32 + r32];
#pragma unroll
    for (int r = 0; r < 16; ++r) {
        const int tl = t0 + crow(r, hi);
        const float wf = __builtin_amdgcn_exp2f(lgf2 * (float)(tl + 1)), wb = __builtin_amdgcn_exp2f(lgb2 * (float)(CH - tl));
        const float v0 = aI[0][r] + wf * aF[0][r] + wb * aB[0][r], v1 = aI[1][r] + wf * aF[1][r] + wb * aB[1][r];
        const float ss = half_sum32(v0 * v0 + v1 * v1); const float rs = __builtin_amdgcn_rsqf(ss * (1.0f / 64.0f) + EPS);
        const LAS unsigned short* grow = (const LAS unsigned short*)(GW + crow(r, hi) * 128) + r32;
        const float ga = bf2f(grow[0]), gb = bf2f(grow[32]);
        const float sa = ga * __builtin_amdgcn_rcpf(1.0f + __builtin_amdgcn_exp2f(-LOG2E * ga)), sb2 = gb * __builtin_amdgcn_rcpf(1.0f + __builtin_amdgcn_exp2f(-LOG2E * gb));
        LAS unsigned short* orow = (LAS unsigned short*)(GW + crow(r, hi) * 128) + r32;
        orow[0] = (unsigned short)(pk2(v0 * rs * g0 * sa, 0.f) & 0xffffu); orow[32] = (unsigned short)(pk2(v1 * rs * g1 * sb2, 0.f) & 0xffffu);
    }
    asm volatile("s_waitcnt lgkmcnt(0)" ::: "memory");
#pragma unroll
    for (int i = 0; i < 4; ++i) { const int pc = lane + 64 * i, rw = pc >> 3, ch = pc & 7;
        *(u32x4*)(MIX + (row0 + t0 + rw) * DM + h * 64 + 8 * ch) = *(const LAS u32x4*)(GW + rw * 128 + ch * 16); }
    __syncthreads();
}

#define XB_TMO      128
#define XB_XCNT(j)  (256  + 64 * (j))
#define XB_XSUB(j)  (1280 + 64 * (j))
#define XB_XGEN(j)  (2304 + 64 * (j))
#define XB_TOP      3328
#define XB_TOPGEN   3392
#define XCD_BAR_WORDS 3456
#define XB_SPIN_CAP (1u << 18)

__device__ __forceinline__ unsigned xb_ld(unsigned* p)              { return __hip_atomic_load(p, __ATOMIC_RELAXED, __HIP_MEMORY_SCOPE_AGENT); }
__device__ __forceinline__ unsigned xb_add(unsigned* p, unsigned v) { return __hip_atomic_fetch_add(p, v, __ATOMIC_RELAXED, __HIP_MEMORY_SCOPE_AGENT); }
__device__ __forceinline__ unsigned xb_xcc_id() { return (unsigned)__builtin_amdgcn_s_getreg((3 << 11) | 20) & 0xFu; }
#define XB_SPIN(cond, bar) do { unsigned _sp = 0; while (cond) { __builtin_amdgcn_s_sleep(1); \
    if ((++_sp & 255u) == 0u) { if (xb_ld(&(bar)[XB_TMO])) break; if (_sp > XB_SPIN_CAP) { atomicAdd(&(bar)[XB_TMO], 1u); break; } } } } while (0)

struct XcdBarrier {
    unsigned* bar; unsigned x;
    volatile LAS unsigned* st;
};

__device__ __forceinline__ XcdBarrier xcd_barrier_post(unsigned* bar, volatile LAS unsigned* st) {
    XcdBarrier b; b.bar = bar; b.x = xb_xcc_id(); b.st = st;
    if (threadIdx.x == 0) (void)xb_add(&bar[XB_XCNT(b.x)], 1u);
    return b;
}
__device__ __forceinline__ void xcd_barrier_complete(unsigned* bar, unsigned x, unsigned& nloc, unsigned& nx) {
    const unsigned G = gridDim.x * gridDim.y * gridDim.z;
    unsigned sum, cnt, mine, sp = 0u;
    for (;;) {
        sum = 0u; cnt = 0u; mine = 0u;
#pragma unroll
        for (unsigned j = 0; j < 16; ++j) { const unsigned c = xb_ld(&bar[XB_XCNT(j)]); sum += c; cnt += (c > 0u) ? 1u : 0u; mine = (j == x) ? c : mine; }
        if (sum == G) break;
        __builtin_amdgcn_s_sleep(1);
        if ((++sp & 255u) == 0u) { if (xb_ld(&bar[XB_TMO])) break; if (sp > XB_SPIN_CAP) { atomicAdd(&bar[XB_TMO], 1u); break; } }
    }
    nloc = mine > 0u ? mine : 1u; nx = cnt > 0u ? cnt : 1u;
}

__device__ __forceinline__ void xcd_barrier(const XcdBarrier& b) {
    asm volatile("s_waitcnt vmcnt(0)" ::: "memory");
    __syncthreads();
    if (threadIdx.x == 0) {
        unsigned* bar = b.bar;
        __builtin_amdgcn_s_waitcnt(0);
        unsigned nloc = b.st[0], nx = b.st[1];
        if (nloc == 0u) { xcd_barrier_complete(bar, b.x, nloc, nx); b.st[0] = nloc; b.st[1] = nx; }
        const unsigned old = xb_add(&bar[XB_XSUB(b.x)], 1u);
        const unsigned gen = old / nloc;
        if (old + 1u == (gen + 1u) * nloc) {
            __builtin_amdgcn_fence(__ATOMIC_RELEASE, "agent");
            asm volatile("s_waitcnt vmcnt(0)" ::: "memory");
            const unsigned og = xb_add(&bar[XB_TOP], 1u);
            const unsigned tg = og / nx;
            if (og + 1u == (tg + 1u) * nx) xb_add(&bar[XB_TOPGEN], 1u);
            else XB_SPIN(xb_ld(&bar[XB_TOPGEN]) == tg, bar);
            __builtin_amdgcn_fence(__ATOMIC_ACQUIRE, "agent");
            xb_add(&bar[XB_XGEN(b.x)], 1u);
            asm volatile("s_waitcnt vmcnt(0)" ::: "memory");
        } else {
            XB_SPIN(xb_ld(&bar[XB_XGEN(b.x)]) == gen, bar);
            __builtin_amdgcn_fence(__ATOMIC_ACQUIRE, "agent");
            asm volatile("s_waitcnt vmcnt(0)" ::: "memory");
        }
    }
    __syncthreads();
}

constexpr int N_PHASES = 1 + 7 * DEPTH;

__global__ void __launch_bounds__(NWAVES * 64, 2) fwd_megakernel(Args args) {
    extern __shared__ __attribute__((aligned(1024))) unsigned char lds_raw[];
    cg::grid_group grid = cg::this_grid();
    Frame F0;
    F0.lds = (LAS unsigned char*)lds_raw;
    F0.tid = threadIdx.x; F0.lane = F0.tid & 63; F0.wave = __builtin_amdgcn_readfirstlane(F0.tid >> 6);
    F0.G = gridDim.x; { const int bx0 = blockIdx.x; F0.vcu = (F0.G % 8 == 0) ? (bx0 % 8) * (F0.G / 8) + bx0 / 8 : bx0; }
    F0.out = args.out; F0.ws = args.ws;
    const int lo = args.ph_lo, hi = args.ph_hi;
    for (int u = threadIdx.x; u < 64; u += NWAVES * 64) ((LAS unsigned*)(F0.lds + LDS_MISC))[u] = 0u;
    __syncthreads();
    (void)xcd_barrier_post((unsigned*)(args.ws + WS_CTL + BAR_OFF), (volatile LAS unsigned*)(F0.lds + LDS_MISC) + 8);
#define IN(k) (lo <= (k) && (k) < hi)
    if (lo < 0) grid.sync();
#define xcd_seam() do { if (IN(pb + 3)) { unsigned char* w_ = args.ws; asm volatile("" : "+s"(w_)); XcdBarrier b_; b_.bar = (unsigned*)(w_ + WS_CTL + BAR_OFF); b_.x = xb_xcc_id(); b_.st = (volatile LAS unsigned*)(F0.lds + LDS_MISC) + 8; xcd_barrier(b_); } } while (0)
#define SEAM(k) do { if (IN(k) && IN((k) + 1)) { unsigned char* w_ = args.ws; asm volatile("" : "+s"(w_)); XcdBarrier b_; b_.bar = (unsigned*)(w_ + WS_CTL + BAR_OFF); b_.x = xb_xcc_id(); b_.st = (volatile LAS unsigned*)(F0.lds + LDS_MISC) + 8; xcd_barrier(b_); } } while (0)
#define PH_BEGIN() Frame F = F0; int bx = (int)blockIdx.x; asm volatile("" : "+s"(F.ws), "+s"(F.out), "+s"(F.G), "+s"(F.vcu), "+s"(bx), "+s"(F.wave), "+v"(F.lane)); F.tid = (F.wave << 6) | F.lane; \
    float* SSQ = (float*)(F.ws + WS_CTL); bf16* XB = (bf16*)(F.ws + WS_XB); bf16* PROJ = (bf16*)(F.ws + WS_PROJ); bf16* MIX = (bf16*)(F.ws + WS_MIX); bf16* HID = (bf16*)(F.ws + WS_HID); \
    (void)SSQ; (void)XB; (void)PROJ; (void)MIX; (void)HID; (void)bx;
#ifndef SKIP_P0
    if (IN(0)) { PH_BEGIN(); p0_prologue(F, args); }
#endif
    SEAM(0);
#pragma unroll
    for (int l = 0; l < DEPTH; ++l) {
        const int pb = 1 + 7 * l;
#ifndef SKIP_G1
        if (IN(pb)) {
            PH_BEGIN();
            pg8::Gemm g{XB, (const bf16*)(F.ws + WS_WIN) + (size_t)l * NPROJ * DM, M, NPROJ, DM}; pg8::StaticOrder S; S.init(M, NPROJ, F.G, bx, WGM_IN);
            pg8::EpiProj E{PROJ, NPROJ, SSQ + (size_t)(2 * l) * M};
            pg8::gemm_phase<pg8::EpiProj, pg8::StaticOrder, true, true>(F.lds, g, S, E, F.tid);
        }
#endif
        SEAM(pb);
        if (IN(pb + 1)) {
            PH_BEGIN();
#ifndef SKIP_RKV
            for (int it = F.vcu; it < BATCH * RH * NCH; it += F.G) ret_kv_item(F, args, l, it);
#endif
            qknorm_pass(F, args, l);
        } SEAM(pb + 1);
        if (IN(pb + 2)) { PH_BEGIN(); ret_scan(F, args, l); } SEAM(pb + 2);
        if (IN(pb + 3)) {
            PH_BEGIN();
#pragma unroll 1
            for (int it = F.vcu; it < 512; it += F.G) {
                const int k = it >> 8, v = it & 255, x = v >> 5, j = v & 31, bb = (x >> 1) & 1, mm = x >> 2;
                const int hh = k == 0 ? 3 - (x & 1) : ((x & 1) ? 1 : 0), qq = (k == 1 && (x & 1)) ? ((j + 16) & 31) : j;
                attn_half(F, args, l, bb, hh, qq, mm);
            }
            {
                const bool g256 = (F.G == 256); const bool take = g256 ? !((F.vcu >> 5) & 1) : true;
                const int rs = g256 ? ((F.vcu >> 6) * 32 + (F.vcu & 31)) : F.vcu, rstride = g256 ? 128 : F.G;
                if (take) {
#pragma unroll 1
                    for (int pr = rs; pr < BATCH * RH * NCH / 2; pr += rstride) ret_out_pair(F, args, l, pr);
                }
            }
        } xcd_seam();
        if (IN(pb + 3)) { PH_BEGIN(); attn_combine(F, args, l); }
        SEAM(pb + 3);
#ifndef SKIP_G2
        if (IN(pb + 4)) {
            PH_BEGIN();
            pg8::Gemm g{MIX, (const bf16*)(F.ws + WS_WOUT) + (size_t)l * DM * DM, M, DM, DM}; pg8::StaticOrder S; S.init(M, DM, F.G, bx, WGM_SQ);
            pg8::EpiRes E{XB, nullptr, SSQ + (size_t)(2 * l + 1) * M};
            pg8::gemm_phase<pg8::EpiRes, pg8::StaticOrder, true, true>(F.lds, g, S, E, F.tid);
        }
#endif
        SEAM(pb + 4);
#ifndef SKIP_G3
        if (IN(pb + 5)) {
            PH_BEGIN();
            pg8::Gemm g{XB, (const bf16*)(F.ws + WS_WGU) + (size_t)l * NGU * DM, M, NGU, DM}; pg8::StaticOrder S; S.init(M, NGU, F.G, bx, WGM_GU);
            pg8::EpiSwiglu E{HID, FF, SSQ + (size_t)(2 * l + 1) * M};
            pg8::gemm_phase<pg8::EpiSwiglu, pg8::StaticOrder, true, true>(F.lds, g, S, E, F.tid);
        }
#endif
        SEAM(pb + 5);
#ifndef SKIP_G4
        if (IN(pb + 6)) {
            PH_BEGIN();
            pg8::Gemm g{HID, (const bf16*)(F.ws + WS_WDN) + (size_t)l * DM * FF, M, DM, FF}; pg8::StaticOrder S; S.init(M, DM, F.G, bx, WGM_SQ);
            const bool last = (l == DEPTH - 1);
            pg8::EpiRes E{XB, last ? F.out : nullptr, SSQ + (size_t)(2 * l + 2 < 4 ? 2 * l + 2 : 0) * M};
            pg8::gemm_phase<pg8::EpiRes, pg8::StaticOrder, true, true>(F.lds, g, S, E, F.tid);
        }
#endif
        SEAM(pb + 6);
    }
#undef IN
#undef SEAM
}

#ifndef MK_N_LAUNCHES
#define MK_N_LAUNCHES 1
#endif
extern "C" void kernel_launch(void* const* d_in, const int* in_sizes, int n_in, void* d_out, int out_size, void* d_ws, size_t ws_size, hipStream_t stream) {
    static int grid = 0;
    if (grid == 0) {
        if (n_in != 18 || out_size != M * DM || ws_size < WS_END) { fprintf(stderr, "kernel_launch: unexpected shapes (n_in %d out %d ws %zu)\n", n_in, out_size, ws_size); grid = -1; return; }
        int dev = 0, cus = 0, per_cu = 0;
        hipGetDevice(&dev); hipDeviceGetAttribute(&cus, hipDeviceAttributeMultiprocessorCount, dev);
        if (hipFuncSetAttribute((const void*)fwd_megakernel, hipFuncAttributeMaxDynamicSharedMemorySize, LDS_BYTES) != hipSuccess) { fprintf(stderr, "kernel_launch: hipFuncSetAttribute failed\n"); grid = -1; return; }
        if (hipOccupancyMaxActiveBlocksPerMultiprocessor(&per_cu, (const void*)fwd_megakernel, NWAVES * 64, LDS_BYTES) != hipSuccess || per_cu < 1) { fprintf(stderr, "kernel_launch: occupancy query failed (%d)\n", per_cu); (void)hipGetLastError(); per_cu = 1; }
        grid = cus * per_cu;
    }
    if (grid < 0) return;
    hipMemsetAsync((char*)d_ws + WS_CTL, 0, CTL_BYTES, stream);
    Args a{};
    for (int i = 0; i < 18; ++i) a.in[i] = (const float*)d_in[i];
    a.out = (float*)d_out; a.ws = (unsigned char*)d_ws;
    const int nl = MK_N_LAUNCHES;
    for (int li = 0; li < nl; ++li) {
        a.ph_lo = (nl == 1) ? 0 : li; a.ph_hi = (nl == 1) ? N_PHASES : li + 1;
        void* kargs[] = {&a};
        hipError_t e = hipLaunchCooperativeKernel((const void*)fwd_megakernel, dim3(grid), dim3(NWAVES * 64), kargs, LDS_BYTES, stream);
        if (e != hipSuccess) { fprintf(stderr, "kernel_launch: cooperative launch %d failed: %s (grid %d)\n", li, hipGetErrorString(e), grid); break; }
    }
}
```

```cpp
#include <hip/hip_runtime.h>
#include <hip/hip_cooperative_groups.h>
#include <cstdio>
#include <cstdint>
namespace cg = cooperative_groups;
namespace pg8 {
#define PG8_LAS __attribute__((address_space(3)))
typedef unsigned short bf16_t;
typedef short bf16x8 __attribute__((ext_vector_type(8)));
typedef float f32x4 __attribute__((ext_vector_type(4)));
typedef unsigned u32x4 __attribute__((ext_vector_type(4)));
constexpr int BM = 256, BK = 64, HALF = 128, HTB = HALF * BK * 2  , STAGE_BYTES = 8 * HTB, NXCD = 8;

__host__ __device__ __forceinline__ int lds_byte(int r, int c) { const int st = (r >> 4) * 2 + (c >> 5), rr = r & 15, cc = c & 31, ob = rr * 64 + cc * 2; return st * 1024 + (ob ^ (((ob >> 9) & 1) << 5)); }
__host__ __device__ __forceinline__ void stage_rc(int b, int& R, int& C) { const int st = b / 1024, sb = b % 1024, swz = sb ^ (((sb >> 9) & 1) << 5); R = (st >> 1) * 16 + swz / 64; C = (st & 1) * 32 + (swz % 64) / 2; }
__host__ __device__ __forceinline__ int perm32(int rho) { const int n = rho >> 4, i = rho & 15; return 8 * (i >> 2) + 4 * n + (i & 3); }

struct Unit { int pm, pn; };
struct Gemm { const bf16_t* A; const bf16_t* Bt; int M, N, K; };

struct StaticOrder {
    int nM, nN, nwg, G, c, WGM;
    __host__ __device__ void init(int M, int N, int G_, int c_, int wgm_) { nM = M / BM; nN = N / BM; nwg = nM * nN; G = G_; c = c_; WGM = wgm_; }
    __host__ __device__ bool next(int i, Unit& u) const {
        const long L = (long)i * G + c; if (L >= nwg) return false;
        int wgid = (int)L; { const int q = nwg / NXCD, r = nwg % NXCD, xcd = wgid % NXCD, off = wgid / NXCD; wgid = (xcd < r ? xcd * (q + 1) : r * (q + 1) + (xcd - r) * q) + off; }
        const int nig = WGM * nN, gid = wgid / nig, fm = gid * WGM, gsz = (nM - fm) < WGM ? (nM - fm) : WGM;
        u.pm = fm + ((wgid % nig) % gsz); u.pn = (wgid % nig) / gsz; return true;
    }
    __device__ __forceinline__ void a_ready(const Unit&) const {}
    __device__ __forceinline__ void done(const Unit&) const {}
};

__device__ __forceinline__ unsigned cvt_pk_bf16(float lo, float hi) { unsigned r; asm volatile("v_cvt_pk_bf16_f32 %0, %1, %2" : "=v"(r) : "v"(lo), "v"(hi)); return r; }
typedef float f32x2 __attribute__((ext_vector_type(2)));
typedef unsigned u32x2 __attribute__((ext_vector_type(2)));
constexpr float RMS_EPS = 1e-6f;
struct EpiProj {
    static constexpr bool PERM = true, AFTER_DRAIN = false;
    bf16_t* O; int ldc; const float* ssq;
    __device__ __forceinline__ void operator()(const f32x4 (&acc)[2][2][4][2], const Unit& u, int wr, int wc, int fr, int fq) const {
        const int row0 = u.pm * BM + wr * 64 + fr, col0 = u.pn * BM + wc * 32 + 8 * fq;
#pragma unroll
        for (int ai = 0; ai < 2; ++ai)
#pragma unroll
            for (int m = 0; m < 4; ++m) { const int row = row0 + ai * HALF + m * 16; const float rs = __builtin_amdgcn_rsqf(ssq[row] * (1.0f / 1024.0f) + RMS_EPS);
                bf16_t* rowp = O + (size_t)row * ldc + col0;
#pragma unroll
                for (int bj = 0; bj < 2; ++bj) { const f32x4 v0 = acc[ai][bj][m][0] * rs, v1 = acc[ai][bj][m][1] * rs;
                    u32x4 w; w.x = cvt_pk_bf16(v0[0], v0[1]); w.y = cvt_pk_bf16(v0[2], v0[3]); w.z = cvt_pk_bf16(v1[0], v1[1]); w.w = cvt_pk_bf16(v1[2], v1[3]);
                    *(u32x4*)(rowp + bj * HALF) = w; } }
    }
};
struct EpiSwiglu {
    static constexpr bool PERM = true, AFTER_DRAIN = false;
    bf16_t* O; int ldc; const float* ssq;
    __device__ __forceinline__ void operator()(const f32x4 (&acc)[2][2][4][2], const Unit& u, int wr, int wc, int fr, int fq) const {
        const int row0 = u.pm * BM + wr * 64 + fr, col0 = u.pn * HALF + wc * 32 + 8 * fq;
#pragma unroll
        for (int ai = 0; ai < 2; ++ai)
#pragma unroll
            for (int m = 0; m < 4; ++m) { const int row = row0 + ai * HALF + m * 16; const float rs = __builtin_amdgcn_rsqf(ssq[row] * (1.0f / 1024.0f) + RMS_EPS);
                float hv[8];
#pragma unroll
                for (int n = 0; n < 2; ++n)
#pragma unroll
                    for (int j = 0; j < 4; ++j) { const float g = acc[ai][0][m][n][j] * rs, up = acc[ai][1][m][n][j] * rs;
                        const float sg = g * __builtin_amdgcn_rcpf(1.0f + __builtin_amdgcn_exp2f(-1.4426950408889634f * g)); hv[n * 4 + j] = sg * up; }
                u32x4 w; w.x = cvt_pk_bf16(hv[0], hv[1]); w.y = cvt_pk_bf16(hv[2], hv[3]); w.z = cvt_pk_bf16(hv[4], hv[5]); w.w = cvt_pk_bf16(hv[6], hv[7]);
                *(u32x4*)(O + (size_t)row * ldc + col0) = w; }
    }
};
struct EpiRes {
    static constexpr bool PERM = true, AFTER_DRAIN = false;
    bf16_t* xb; float* out; float* ssq;
    __device__ __forceinline__ void operator()(const f32x4 (&acc)[2][2][4][2], const Unit& u, int wr, int wc, int fr, int fq) const {
        const int row0 = u.pm * BM + wr * 64 + fr, col0 = u.pn * BM + wc * 32 + 8 * fq;
#pragma unroll
        for (int ai = 0; ai < 2; ++ai)
#pragma unroll
            for (int m = 0; m < 4; ++m) { const int row = row0 + ai * HALF + m * 16; const size_t off = (size_t)row * 1024 + col0; float part = 0.f;
#pragma unroll
                for (int bj = 0; bj < 2; ++bj) { const size_t o = off + bj * HALF; const u32x4 rb = *(const u32x4*)(xb + o);
                    f32x4 v0, v1;
                    v0[0] = __uint_as_float(rb.x << 16) + acc[ai][bj][m][0][0]; v0[1] = __uint_as_float(rb.x & 0xffff0000u) + acc[ai][bj][m][0][1];
                    v0[2] = __uint_as_float(rb.y << 16) + acc[ai][bj][m][0][2]; v0[3] = __uint_as_float(rb.y & 0xffff0000u) + acc[ai][bj][m][0][3];
                    v1[0] = __uint_as_float(rb.z << 16) + acc[ai][bj][m][1][0]; v1[1] = __uint_as_float(rb.z & 0xffff0000u) + acc[ai][bj][m][1][1];
                    v1[2] = __uint_as_float(rb.w << 16) + acc[ai][bj][m][1][2]; v1[3] = __uint_as_float(rb.w & 0xffff0000u) + acc[ai][bj][m][1][3];
                    if (out) { *(f32x4*)(out + o) = v0; *(f32x4*)(out + o + 4) = v1; }
                    else { part += ((v0[0] * v0[0] + v0[1] * v0[1]) + (v0[2] * v0[2] + v0[3] * v0[3])) + ((v1[0] * v1[0] + v1[1] * v1[1]) + (v1[2] * v1[2] + v1[3] * v1[3]));
                        u32x4 w; w.x = cvt_pk_bf16(v0[0], v0[1]); w.y = cvt_pk_bf16(v0[2], v0[3]); w.z = cvt_pk_bf16(v1[0], v1[1]); w.w = cvt_pk_bf16(v1[2], v1[3]); *(u32x4*)(xb + o) = w; } }
                if (!out) { part += __shfl_xor(part, 16); part += __shfl_xor(part, 32);
                    if (fq == 0) __hip_atomic_fetch_add(ssq + row, part, __ATOMIC_RELAXED, __HIP_MEMORY_SCOPE_AGENT); } }
    }
};
template <class Epi, class Sched, bool ALIGN_EPI = false, bool SP2 = false>
__device__ __forceinline__ void gemm_phase(PG8_LAS unsigned char* lds, const Gemm g, const Sched& S, const Epi& E, const int tid_in) {
    const int tid = tid_in, wid = __builtin_amdgcn_readfirstlane(tid >> 6), lane = tid & 63, wr = wid >> 2, wc = wid & 3, fr = lane & 15, fq = lane >> 4;
    const int K = g.K, nt = K / BK;
    unsigned voffA[2], voffB[2];
#pragma unroll
    for (int i = 0; i < 2; ++i) { int R, C; stage_rc(tid * 16 + i * 8192, R, C); const int Rb = Epi::PERM ? ((R & ~31) + perm32(R & 31)) : R;
        voffA[i] = (unsigned)(R * K + C) * 2u; voffB[i] = (unsigned)(Rb * K + C) * 2u; }
    const size_t kstep = (size_t)(BK * 2);
    const size_t hstep = (size_t)HALF * K * 2;
    const size_t tstep = 2 * hstep;
    const unsigned ldsw = (unsigned)wid * 1024u;
    const int aoff = lds_byte(wr * 64 + fr, fq * 8), boff = lds_byte(wc * 32 + fr, fq * 8);
#define PG8_SA(b, h) (((b) * 2 + (h)) * HTB)
#define PG8_SB(b, h) ((4 + (b) * 2 + (h)) * HTB)
#define PG8_STAGE(bufoff, gbase, voff) do { _Pragma("unroll") for (int _i = 0; _i < 2; ++_i) \
        __builtin_amdgcn_global_load_lds((const unsigned*)((const char*)(gbase) + (voff)[_i]), (PG8_LAS unsigned*)(lds + (bufoff) + ldsw + _i * 8192), 16, 0, 0); } while (0)
#define PG8_LDA(dst, b, h) do { _Pragma("unroll") for (int m = 0; m < 4; ++m) _Pragma("unroll") for (int k = 0; k < 2; ++k) dst[m][k] = *(const PG8_LAS bf16x8*)(lds + PG8_SA(b, h) + aoff + m * 2048 + k * 1024); } while (0)
#define PG8_LDB(dst, b, h) do { _Pragma("unroll") for (int n = 0; n < 2; ++n) _Pragma("unroll") for (int k = 0; k < 2; ++k) dst[n][k] = *(const PG8_LAS bf16x8*)(lds + PG8_SB(b, h) + boff + n * 2048 + k * 1024); } while (0)
#define PG8_MMA(ai, bj, At, Bt) do { __builtin_amdgcn_s_setprio(1); _Pragma("unroll") for (int m = 0; m < 4; ++m) _Pragma("unroll") for (int n = 0; n < 2; ++n) _Pragma("unroll") for (int k = 0; k < 2; ++k) \
        acc[ai][bj][m][n] = __builtin_amdgcn_mfma_f32_16x16x32_bf16(Bt[n][k], At[m][k], acc[ai][bj][m][n], 0, 0, 0); __builtin_amdgcn_s_setprio(0); } while (0)
#define PG8_WAIT_V(n) asm volatile("s_waitcnt vmcnt(" #n ")" ::: "memory")
#define PG8_WAIT_L(n) asm volatile("s_waitcnt lgkmcnt(" #n ")" ::: "memory")
#define PG8_BAR __builtin_amdgcn_s_barrier()
#define PG8_SCHED __builtin_amdgcn_sched_barrier(0)
    Unit cur, nxt; int ui = 0;
    if (!S.next(0, cur)) return;
    f32x4 acc[2][2][4][2];
#pragma unroll
    for (int a = 0; a < 2; ++a)
#pragma unroll
        for (int b = 0; b < 2; ++b)
#pragma unroll
            for (int m = 0; m < 4; ++m)
#pragma unroll
                for (int n = 0; n < 2; ++n) acc[a][b][m][n] = (f32x4){0.f, 0.f, 0.f, 0.f};
    bf16x8 At[4][2], B0[2][2], B1[2][2];
    const char* cA = (const char*)g.A + (size_t)cur.pm * tstep; const char* cB = (const char*)g.Bt + (size_t)cur.pn * tstep;
    S.a_ready(cur);
    if constexpr (SP2) {
        PG8_STAGE(PG8_SB(0, 0), cB, voffB); PG8_STAGE(PG8_SB(0, 1), cB + hstep, voffB); PG8_STAGE(PG8_SA(0, 0), cA, voffA); PG8_STAGE(PG8_SA(0, 1), cA + hstep, voffA);
        if (wr == 1) PG8_BAR;
        PG8_WAIT_V(2); PG8_BAR;
        PG8_STAGE(PG8_SB(1, 0), cB + kstep, voffB); PG8_STAGE(PG8_SA(1, 0), cA + kstep, voffA); PG8_STAGE(PG8_SB(1, 1), cB + hstep + kstep, voffB);
        PG8_WAIT_V(6); PG8_BAR;
    } else {
        PG8_STAGE(PG8_SB(0, 0), cB, voffB); PG8_STAGE(PG8_SA(0, 0), cA, voffA); PG8_STAGE(PG8_SB(0, 1), cB + hstep, voffB); PG8_STAGE(PG8_SA(0, 1), cA + hstep, voffA);
        if (wr == 1) PG8_BAR;
        PG8_WAIT_V(4); PG8_BAR;
        PG8_STAGE(PG8_SB(1, 0), cB + kstep, voffB); PG8_STAGE(PG8_SA(1, 0), cA + kstep, voffA); PG8_STAGE(PG8_SB(1, 1), cB + hstep + kstep, voffB);
        PG8_WAIT_V(6); PG8_BAR;
    }
    for (;;) {
        const bool has_next = S.next(ui + 1, nxt);
        const char* nA = has_next ? (const char*)g.A + (size_t)nxt.pm * tstep : cA; const char* nB = has_next ? (const char*)g.Bt + (size_t)nxt.pn * tstep : cB;
        for (int t = 0; t < nt; t += 2) {
            const bool last = (t == nt - 2);
            const char* a1 = cA + (size_t)(t + 1) * kstep;
            const char* a2 = last ? nA : cA + (size_t)(t + 2) * kstep; const char* b2 = last ? nB : cB + (size_t)(t + 2) * kstep;
            const char* a3 = a2 + kstep; const char* b3 = b2 + kstep;
            if (last && has_next) S.a_ready(nxt);
            if constexpr (SP2) {
            PG8_LDB(B0, 0, 0); PG8_LDB(B1, 0, 1); PG8_SCHED; PG8_LDA(At, 0, 0); PG8_STAGE(PG8_SA(1, 1), a1 + hstep, voffA);
            PG8_WAIT_V(8); PG8_WAIT_L(0); PG8_BAR; PG8_MMA(0, 0, At, B0); PG8_MMA(0, 1, At, B1); PG8_BAR; PG8_SCHED;
            PG8_LDA(At, 0, 1); PG8_STAGE(PG8_SB(0, 0), b2, voffB); PG8_STAGE(PG8_SB(0, 1), b2 + hstep, voffB); PG8_STAGE(PG8_SA(0, 0), a2, voffA);
            PG8_WAIT_V(8); PG8_WAIT_L(0); PG8_BAR; PG8_MMA(1, 0, At, B0); PG8_MMA(1, 1, At, B1); PG8_BAR; PG8_SCHED;
            PG8_LDB(B0, 1, 0); PG8_LDB(B1, 1, 1); PG8_SCHED; PG8_LDA(At, 1, 0); PG8_STAGE(PG8_SA(0, 1), a2 + hstep, voffA);
            PG8_WAIT_V(8); PG8_WAIT_L(0); PG8_BAR; PG8_MMA(0, 0, At, B0); PG8_MMA(0, 1, At, B1); PG8_BAR; PG8_SCHED;
            PG8_LDA(At, 1, 1); PG8_STAGE(PG8_SB(1, 0), b3, voffB); PG8_STAGE(PG8_SB(1, 1), b3 + hstep, voffB); PG8_STAGE(PG8_SA(1, 0), a3, voffA);
            PG8_WAIT_V(8); PG8_WAIT_L(0); PG8_BAR; PG8_MMA(1, 0, At, B0); PG8_MMA(1, 1, At, B1); PG8_BAR; PG8_SCHED;
            } else {
            PG8_LDB(B0, 0, 0); PG8_SCHED; PG8_LDA(At, 0, 0); PG8_STAGE(PG8_SA(1, 1), a1 + hstep, voffA);
            PG8_WAIT_L(8); PG8_BAR; PG8_WAIT_L(0); PG8_MMA(0, 0, At, B0); PG8_BAR; PG8_SCHED;
            PG8_LDB(B1, 0, 1); PG8_STAGE(PG8_SB(0, 0), b2, voffB);
            PG8_BAR; PG8_WAIT_L(0); PG8_MMA(0, 1, At, B1); PG8_BAR;
            PG8_LDA(At, 0, 1); PG8_STAGE(PG8_SA(0, 0), a2, voffA);
            PG8_BAR; PG8_WAIT_L(0); PG8_MMA(1, 0, At, B0); PG8_BAR; PG8_SCHED;
            PG8_STAGE(PG8_SB(0, 1), b2 + hstep, voffB);
            PG8_WAIT_V(6); PG8_BAR; PG8_MMA(1, 1, At, B1); PG8_BAR;
            PG8_LDB(B0, 1, 0); PG8_SCHED; PG8_LDA(At, 1, 0); PG8_STAGE(PG8_SA(0, 1), a2 + hstep, voffA);
            PG8_WAIT_L(8); PG8_BAR; PG8_WAIT_L(0); PG8_MMA(0, 0, At, B0); PG8_BAR; PG8_SCHED;
            PG8_LDB(B1, 1, 1); PG8_STAGE(PG8_SB(1, 0), b3, voffB);
            PG8_BAR; PG8_WAIT_L(0); PG8_MMA(0, 1, At, B1); PG8_BAR;
            PG8_LDA(At, 1, 1); PG8_STAGE(PG8_SA(1, 0), a3, voffA);
            PG8_BAR; PG8_WAIT_L(0); PG8_MMA(1, 0, At, B0); PG8_BAR; PG8_SCHED;
            PG8_STAGE(PG8_SB(1, 1), b3 + hstep, voffB);
            PG8_WAIT_V(6); PG8_BAR; PG8_MMA(1, 1, At, B1); PG8_BAR;
            }
        }
        if constexpr (ALIGN_EPI) { if (wr == 0) PG8_BAR; }
        if constexpr (!Epi::AFTER_DRAIN) { E(acc, cur, wr, wc, fr, fq); S.done(cur); }
        if (!has_next) break;
#pragma unroll
        for (int a = 0; a < 2; ++a)
#pragma unroll
            for (int b = 0; b < 2; ++b)
#pragma unroll
                for (int m = 0; m < 4; ++m)
#pragma unroll
                    for (int n = 0; n < 2; ++n) acc[a][b][m][n] = (f32x4){0.f, 0.f, 0.f, 0.f};
        cur = nxt; cA = nA; cB = nB; ++ui;
        if constexpr (ALIGN_EPI) { if (wr == 1) PG8_BAR; }
    }
    PG8_WAIT_V(0);
    if constexpr (!ALIGN_EPI) { if (wr == 0) PG8_BAR; }
    PG8_BAR;
    if constexpr (Epi::AFTER_DRAIN) { E.fused(acc, cur, wr, wc, fr, fq, lds, wid, lane); S.done(cur); }
#undef PG8_SA
#undef PG8_SB
#undef PG8_STAGE
#undef PG8_LDA
#undef PG8_LDB
#undef PG8_MMA
#undef PG8_WAIT_V
#undef PG8_WAIT_L
#undef PG8_BAR
#undef PG8_SCHED
}
}

constexpr int BATCH = 2, SEQ = 8192, DM = 1024, DEPTH = 2;
constexpr int M = BATCH * SEQ;
constexpr int NPROJ = 3584, FF = 2816, NGU = 2 * FF;
constexpr int RH = 8, CH = 128, NCH = SEQ / CH;
constexpr int C_RQ = 0, C_RK = 512, C_RV = 1024, C_RG = 1536, C_DQ = 2048, C_DK = 2560, C_DV = 3072;
constexpr float EPS = 1e-6f, LOG2E = 1.4426950408889634f;
constexpr size_t MiB = 1u << 20;
constexpr size_t WS_CTL = 0, CTL_BYTES = 1 * MiB;
constexpr size_t WS_WIN = 1 * MiB, WS_WOUT = 15 * MiB, WS_WGU = 19 * MiB, WS_WDN = 41 * MiB;
constexpr size_t WS_XB = 52 * MiB;
constexpr size_t WS_MIX = 84 * MiB, WS_PROJ = 116 * MiB, WS_HID = 116 * MiB, WS_RF = 228 * MiB, WS_RB = 236 * MiB, WS_END = 244 * MiB;
constexpr size_t PAR_OFF = 512 * 1024, BAR_OFF = 768 * 1024;
constexpr int LDS_MISC = 131072;
constexpr int LDS_BYTES = 135168;
constexpr int NWAVES = 8;
#ifndef WGM_IN
#define WGM_IN 4
#endif
#ifndef WGM_GU
#define WGM_GU 4
#endif
#ifndef WGM_SQ
#define WGM_SQ 8
#endif

#define LAS __attribute__((address_space(3)))
typedef unsigned short bf16;
typedef short bf16x8 __attribute__((ext_vector_type(8)));
typedef short s16x4 __attribute__((ext_vector_type(4)));
typedef short v4i16_t __attribute__((ext_vector_type(4)));
typedef float f32x4 __attribute__((ext_vector_type(4)));
typedef float f32x16 __attribute__((ext_vector_type(16)));
typedef unsigned u32x4 __attribute__((ext_vector_type(4)));
typedef float f32x2_t __attribute__((ext_vector_type(2)));
typedef __bf16 bf16x2_t __attribute__((ext_vector_type(2)));

__device__ __forceinline__ unsigned pk2(float lo, float hi) { f32x2_t v = {lo, hi}; bf16x2_t b = __builtin_convertvector(v, bf16x2_t); return __builtin_bit_cast(unsigned, b); }
__device__ __forceinline__ float bf2f(unsigned short b) { return __uint_as_float((unsigned)b << 16); }
__device__ __forceinline__ float bflo(unsigned w) { return __uint_as_float(w << 16); }
__device__ __forceinline__ float bfhi(unsigned w) { return __uint_as_float(w & 0xffff0000u); }
__device__ __forceinline__ int crow(int r, int hi) { return (r & 3) + 8 * (r >> 2) + 4 * hi; }
__device__ __forceinline__ s16x4 vtr(const LAS unsigned char* p) { return __builtin_bit_cast(s16x4, __builtin_amdgcn_ds_read_tr16_b64_v4i16((LAS v4i16_t*)p)); }
__device__ __forceinline__ bf16x8 cat8(s16x4 lo, s16x4 hi) { return (bf16x8){lo[0], lo[1], lo[2], lo[3], hi[0], hi[1], hi[2], hi[3]}; }
__device__ __forceinline__ void glds16(const void* g, LAS unsigned char* l) { __builtin_amdgcn_global_load_lds((const unsigned*)g, (LAS unsigned*)l, 16, 0, 0); }
__device__ __forceinline__ void glds16a(const void* g, unsigned lds_dst) { unsigned keep; asm volatile("s_mov_b32 %0, m0\n\ts_mov_b32 m0, %2\n\ts_nop 0\n\tglobal_load_lds_dwordx4 %1, off\n\ts_mov_b32 m0, %0" : "=&s"(keep) : "v"(g), "s"(lds_dst) : "memory"); }
#define MFMA32(a, b, c) __builtin_amdgcn_mfma_f32_32x32x16_bf16((a), (b), (c), 0, 0, 0)
#define VMWAIT0() asm volatile("s_waitcnt vmcnt(0)" ::: "memory")
__device__ __forceinline__ float wave_sum(float v) {
#pragma unroll
    for (int o = 1; o < 64; o <<= 1) v += __shfl_xor(v, o);
    return v;
}
__device__ __forceinline__ float half_sum32(float v) {
#pragma unroll
    for (int o = 1; o < 32; o <<= 1) v += __shfl_xor(v, o);
    return v;
}

struct Params { float lam[DEPTH]; float b2[DEPTH]; };

struct CvItem { const float* W; bf16* WT; const float* gk; int K, N, r0, k0, n0; };
__device__ __forceinline__ void cv_load(const CvItem& c, f32x4 (&v8)[8], int lane) {
#pragma unroll
    for (int i = 0; i < 8; ++i) v8[i] = *(const f32x4*)(c.W + (size_t)(c.k0 + 8 * i + (lane >> 3)) * c.N + c.n0 + 4 * (lane & 7));
}
__device__ __forceinline__ void cv_store(const CvItem& c, const f32x4 (&v8)[8], LAS float* scr, int lane) {
#pragma unroll
    for (int i = 0; i < 8; ++i) { LAS float* d = scr + (8 * i + (lane >> 3)) * 33 + 4 * (lane & 7); d[0] = v8[i].x; d[1] = v8[i].y; d[2] = v8[i].z; d[3] = v8[i].w; }
    asm volatile("s_waitcnt lgkmcnt(0)" ::: "memory");
    const int cc = lane & 7;
    float g8[8];
#pragma unroll
    for (int i = 0; i < 8; ++i) g8[i] = c.gk ? c.gk[c.k0 + 8 * cc + i] : 1.0f;
#pragma unroll
    for (int j = 0; j < 4; ++j) { const int n = (lane >> 3) + 8 * j; const LAS float* sp = scr + (8 * cc) * 33 + n;
        u32x4 o; o.x = pk2(sp[0 * 33] * g8[0], sp[1 * 33] * g8[1]); o.y = pk2(sp[2 * 33] * g8[2], sp[3 * 33] * g8[3]); o.z = pk2(sp[4 * 33] * g8[4], sp[5 * 33] * g8[5]); o.w = pk2(sp[6 * 33] * g8[6], sp[7 * 33] * g8[7]);
        *(u32x4*)(c.WT + (size_t)(c.r0 + n) * c.K + c.k0 + 8 * cc) = o; }
    asm volatile("s_waitcnt lgkmcnt(0)" ::: "memory");
}
__device__ __forceinline__ void row_load(const float* xrow, f32x4 (&v)[4], int lane) {
    const f32x4* xr = (const f32x4*)xrow + lane;
#pragma unroll
    for (int j = 0; j < 4; ++j) v[j] = xr[64 * j];
}
__device__ __forceinline__ void row_store(const f32x4 (&v)[4], bf16* orow, float* ssq, int lane) {
    float s = 0.f;
#pragma unroll
    for (int j = 0; j < 4; ++j) s += (v[j].x * v[j].x + v[j].y * v[j].y) + (v[j].z * v[j].z + v[j].w * v[j].w);
    s = wave_sum(s);
    unsigned long long* o8 = (unsigned long long*)orow + lane;
#pragma unroll
    for (int j = 0; j < 4; ++j) o8[64 * j] = (unsigned long long)pk2(v[j].x, v[j].y) | ((unsigned long long)pk2(v[j].z, v[j].w) << 32);
    if (lane == 0) *ssq = s;
}

struct Args { const float* in[18]; float* out; unsigned char* ws; int ph_lo, ph_hi; };
struct Frame {
    LAS unsigned char* lds;
    float* out; unsigned char* ws;
    int tid, lane, wave, vcu, G;
};

__device__ __forceinline__ CvItem cv_decode(const Args& A, unsigned char* ws, int it) {
    constexpr int I_IN = (DM / 64) * (NPROJ / 32), I_OUT = (DM / 64) * (DM / 32), I_G = (DM / 64) * (FF / 32), I_D = (FF / 64) * (DM / 32);
    constexpr int PER_LAYER = I_IN + I_OUT + 2 * I_G + I_D;
    const int l = it / PER_LAYER; int r = it % PER_LAYER; CvItem c; int rowmap = 0;
    if (r < I_IN) { c.W = A.in[2] + (size_t)l * DM * NPROJ; c.K = DM; c.N = NPROJ; c.WT = (bf16*)(ws + WS_WIN) + (size_t)l * NPROJ * DM; c.gk = A.in[1] + l * DM; }
    else if ((r -= I_IN) < I_OUT) { c.W = A.in[13] + (size_t)l * DM * DM; c.K = DM; c.N = DM; c.WT = (bf16*)(ws + WS_WOUT) + (size_t)l * DM * DM; c.gk = nullptr; }
    else if ((r -= I_OUT) < I_G) { c.W = A.in[15] + (size_t)l * DM * FF; c.K = DM; c.N = FF; c.WT = (bf16*)(ws + WS_WGU) + (size_t)l * NGU * DM; c.gk = A.in[14] + l * DM; rowmap = 1; }
    else if ((r -= I_G) < I_G) { c.W = A.in[16] + (size_t)l * DM * FF; c.K = DM; c.N = FF; c.WT = (bf16*)(ws + WS_WGU) + (size_t)l * NGU * DM; c.gk = A.in[14] + l * DM; rowmap = 2; }
    else { r -= I_G; c.W = A.in[17] + (size_t)l * FF * DM; c.K = FF; c.N = DM; c.WT = (bf16*)(ws + WS_WDN) + (size_t)l * DM * FF; c.gk = nullptr; }
    const int nblk = c.N / 32, kb = r / nblk, nb = r % nblk; c.k0 = 64 * kb; c.n0 = 32 * nb;
    c.r0 = rowmap == 0 ? c.n0 : ((c.n0 >> 7) * 256 + (c.n0 & 127) + (rowmap == 2 ? 128 : 0));
    return c;
}
__device__ __forceinline__ void p0_prologue(Frame& F, const Args& A) {
    LAS float* scr = (LAS float*)(F.lds + F.wave * 16384);
    const int gw = F.vcu * NWAVES + F.wave, NGW = F.G * NWAVES;
    constexpr int TOT = DEPTH * ((DM / 64) * (NPROJ / 32) + (DM / 64) * (DM / 32) + 2 * (DM / 64) * (FF / 32) + (FF / 64) * (DM / 32));
    {
        int it = gw; CvItem c; f32x4 v[8];
        if (it < TOT) { c = cv_decode(A, F.ws, it); cv_load(c, v, F.lane); }
#pragma unroll 1
        while (it < TOT) {
            const int itn = it + NGW; const bool hn = itn < TOT; CvItem cn = c; f32x4 vn[8];
            if (hn) { cn = cv_decode(A, F.ws, itn); cv_load(cn, vn, F.lane); }
            cv_store(c, v, scr, F.lane);
            if (hn) { c = cn;
#pragma unroll
                for (int i = 0; i < 8; ++i) v[i] = vn[i]; }
            it = itn;
        }
    }
    float* ssq0 = (float*)(F.ws + WS_CTL);
    {
        int m = gw; f32x4 v[4];
        if (m < M) row_load(A.in[0] + (size_t)m * DM, v, F.lane);
#pragma unroll 1
        while (m < M) {
            const int mn = m + NGW; const bool hn = mn < M; f32x4 vn[4];
            if (hn) row_load(A.in[0] + (size_t)mn * DM, vn, F.lane);
            row_store(v, (bf16*)(F.ws + WS_XB) + (size_t)m * DM, ssq0 + m, F.lane);
            if (hn) {
#pragma unroll
                for (int j = 0; j < 4; ++j) v[j] = vn[j]; }
            m = mn;
        }
    }
    if (blockIdx.x == 0 && F.wave == 0) {
        Params* P = (Params*)(F.ws + WS_CTL + PAR_OFF);
        for (int l = 0; l < DEPTH; ++l) {
            const float a = wave_sum(A.in[8][l * 64 + F.lane] * A.in[9][l * 64 + F.lane]), b = wave_sum(A.in[10][l * 64 + F.lane] * A.in[11][l * 64 + F.lane]);
            const float lam_init = 0.8f - 0.6f * expf(-0.3f * (float)l);
            if (F.lane == 0) P->lam[l] = expf(a) - expf(b) + lam_init;
            float gq = fabsf(A.in[6][l * 64 + F.lane]), gk = fabsf(A.in[7][l * 64 + F.lane]);
#pragma unroll
            for (int o = 1; o < 64; o <<= 1) { gq = fmaxf(gq, __shfl_xor(gq, o)); gk = fmaxf(gk, __shfl_xor(gk, o)); }
            if (F.lane == 0) P->b2[l] = 8.0f * LOG2E * 1.02f * gq * gk;
        }
    }
}

__device__ __forceinline__ void qknorm_pass(Frame& F, const Args& A, int l) {
    bf16* PROJ = (bf16*)(F.ws + WS_PROJ);
    const int c = F.tid & 127, sub = F.tid >> 7;
    const bool isq = c < 64; const int d0 = (8 * c) & 63;
    const float* g = (isq ? A.in[6] : A.in[7]) + l * 64 + d0; const float sc = isq ? 0.125f * LOG2E : 1.0f;
    float g8[8];
#pragma unroll
    for (int i = 0; i < 8; ++i) g8[i] = g[i] * sc;
    for (int it0 = F.vcu; it0 < M / 4; it0 += 4 * F.G) {
        u32x4 wv[4];
#pragma unroll
        for (int q = 0; q < 4; ++q) { const int it = it0 + q * F.G; if (it < M / 4) wv[q] = *(const u32x4*)(PROJ + (size_t)(4 * it + sub) * NPROJ + C_DQ + 8 * c); }
#pragma unroll
        for (int q = 0; q < 4; ++q) { const int it = it0 + q * F.G; if (it < M / 4) {
            u32x4* p = (u32x4*)(PROJ + (size_t)(4 * it + sub) * NPROJ + C_DQ + 8 * c);
            const u32x4 w = wv[q]; float x[8] = {bflo(w.x), bfhi(w.x), bflo(w.y), bfhi(w.y), bflo(w.z), bfhi(w.z), bflo(w.w), bfhi(w.w)};
            float ss = 0.f;
#pragma unroll
            for (int i = 0; i < 8; ++i) ss += x[i] * x[i];
            ss += __shfl_xor(ss, 1); ss += __shfl_xor(ss, 2); ss += __shfl_xor(ss, 4);
            const float r = __builtin_amdgcn_rsqf(ss * (1.0f / 64.0f) + EPS);
            u32x4 o; o.x = pk2(x[0] * r * g8[0], x[1] * r * g8[1]); o.y = pk2(x[2] * r * g8[2], x[3] * r * g8[3]); o.z = pk2(x[4] * r * g8[4], x[5] * r * g8[5]); o.w = pk2(x[6] * r * g8[6], x[7] * r * g8[7]);
            *p = o; } }
    }
}
__device__ __forceinline__ int tr_off128(int lane, int r0, int cb) { return (r0 + ((lane & 15) >> 2)) * 128 + (32 * cb + 16 * ((lane >> 4) & 1)) * 2 + 8 * (lane & 3); }

__device__ __forceinline__ void ret_kv_item(Frame& F, const Args& A, int l, int item) {
    const bf16* PROJ = (const bf16*)(F.ws + WS_PROJ);
    const int n = item & 63, h = (item >> 6) & 7, b = item >> 9;
    int lane_ = F.lane; asm volatile("" : "+v"(lane_));
    const int tid_ = (F.wave << 6) | lane_;
    const float lgf2 = -expf(A.in[3][l * RH + h]) * LOG2E, lgb2 = -expf(A.in[4][l * RH + h]) * LOG2E;
    const size_t row0 = (size_t)b * SEQ + (size_t)n * CH;
    LAS unsigned char* LK = F.lds; LAS unsigned char* LVF = F.lds + 16384; LAS unsigned char* LVB = F.lds + 32768;
#pragma unroll
    for (int i = 0; i < 2; ++i) { const int pc = tid_ + 512 * i, s = pc >> 3, ch = pc & 7;
        const u32x4 kw = *(const u32x4*)(PROJ + (row0 + s) * NPROJ + C_RK + h * 64 + 8 * ch);
        const u32x4 vw = *(const u32x4*)(PROJ + (row0 + s) * NPROJ + C_RV + h * 64 + 8 * ch);
        *(LAS u32x4*)(LK + s * 128 + ch * 16) = kw;
        const float wf = __builtin_amdgcn_exp2f(lgf2 * (float)(CH - 1 - s)) * 0.125f, wb = __builtin_amdgcn_exp2f(lgb2 * (float)s) * 0.125f;
        const float x[8] = {bflo(vw.x), bfhi(vw.x), bflo(vw.y), bfhi(vw.y), bflo(vw.z), bfhi(vw.z), bflo(vw.w), bfhi(vw.w)};
        u32x4 a, c2;
        a.x = pk2(x[0] * wf, x[1] * wf); a.y = pk2(x[2] * wf, x[3] * wf); a.z = pk2(x[4] * wf, x[5] * wf); a.w = pk2(x[6] * wf, x[7] * wf);
        c2.x = pk2(x[0] * wb, x[1] * wb); c2.y = pk2(x[2] * wb, x[3] * wb); c2.z = pk2(x[4] * wb, x[5] * wb); c2.w = pk2(x[6] * wb, x[7] * wb);
        *(LAS u32x4*)(LVF + s * 128 + ch * 16) = a; *(LAS u32x4*)(LVB + s * 128 + ch * 16) = c2; }
    __syncthreads();
    const int dir = F.wave >> 2, db = (F.wave >> 1) & 1, eb = F.wave & 1, hi = lane_ >> 5;
    const LAS unsigned char* LV = dir ? LVB : LVF;
    const int tb8 = (8 * hi + ((lane_ & 15) >> 2)) * 128 + 32 * ((lane_ >> 4) & 1) + 8 * (lane_ & 3);
    const LAS unsigned char* pa = LK + tb8 + 64 * db; const LAS unsigned char* pb_ = LV + tb8 + 64 * eb;
    f32x16 acc = {};
#pragma unroll
    for (int st = 0; st < 8; ++st) {
        const bf16x8 a = cat8(vtr(pa + st * 2048), vtr(pa + st * 2048 + 512));
        const bf16x8 bb = cat8(vtr(pb_ + st * 2048), vtr(pb_ + st * 2048 + 512));
        acc = MFMA32(a, bb, acc);
    }
    float* KV = (float*)((unsigned char*)F.out + (dir ? 16 * MiB : 0)) + (size_t)item * 4096;
#pragma unroll
    for (int r = 0; r < 16; ++r) KV[(32 * db + crow(r, hi)) * 64 + 32 * eb + (lane_ & 31)] = acc[r];
    __syncthreads();
}

__device__ __forceinline__ void ret_scan(Frame& F, const Args& A, int l) {
    const int total = 2 * BATCH * RH * 4096;
    for (int gid = F.vcu * 512 + F.tid; gid < total; gid += F.G * 512) {
        const int dir = gid / (BATCH * RH * 4096), rem = gid % (BATCH * RH * 4096), bh = rem >> 12, el = rem & 4095, h = bh & 7;
        const float lg = -expf((dir ? A.in[4] : A.in[3])[l * RH + h]); const float dc = expf(lg * (float)CH);
        const float* KV = (const float*)((unsigned char*)F.out + (dir ? 16 * MiB : 0)) + (size_t)bh * NCH * 4096 + el;
        bf16* R = (bf16*)(F.ws + (dir ? WS_RB : WS_RF)) + (size_t)bh * NCH * 4096 + el;
        float st = 0.f;
#pragma unroll 1
        for (int blk = 0; blk < NCH / 32; ++blk) {
            float kv[32];
            if (dir == 0) {
#pragma unroll
                for (int j = 0; j < 32; ++j) kv[j] = KV[(size_t)(blk * 32 + j) * 4096];
#pragma unroll
                for (int j = 0; j < 32; ++j) { R[(size_t)(blk * 32 + j) * 4096] = (bf16)(pk2(st, 0.f) & 0xffffu); st = dc * st + kv[j]; }
            } else {
#pragma unroll
                for (int j = 0; j < 32; ++j) kv[j] = KV[(size_t)(NCH - 1 - blk * 32 - j) * 4096];
#pragma unroll
                for (int j = 0; j < 32; ++j) { R[(size_t)(NCH - 1 - blk * 32 - j) * 4096] = (bf16)(pk2(st, 0.f) & 0xffffu); st = dc * st + kv[j]; }
            }
        }
    }
}

__device__ __forceinline__ void attn_half(Frame& F, const Args& A, int l, int b, int h, int qb, int m) {
    const bf16* PROJ = (const bf16*)(F.ws + WS_PROJ); bf16* OB = (bf16*)((unsigned char*)F.out + 32 * MiB) + (size_t)m * M * 512;
    int lane = F.lane; asm volatile("" : "+v"(lane));
    const int r32 = lane & 31, hi = lane >> 5, wid = F.wave;
    const size_t rowbase = (size_t)b * SEQ; const int q0 = qb * 256 + wid * 32;
    const float B2 = ((const Params*)(F.ws + WS_CTL + PAR_OFF))->b2[l];
    const float slope2 = exp2f(-2.0f * (float)(h + 1)) * LOG2E, nslope2 = -slope2;
    const int dthr = (int)(150.0f / slope2) + 1;
    const int t_lo = max(0, ((qb * 256 - 63 - dthr) >> 6) + 1), t_hi = min(SEQ / 64, (qb * 256 + 255 + dthr + 63) >> 6);
    LAS unsigned char* lds = F.lds;
    LAS float* wsf = (LAS float*)(lds + 73728) + wid * 64;
    const bf16* kvb = PROJ + rowbase * NPROJ;
    const bf16* vsrc = kvb + (size_t)(16 * (wid & 3) + (lane >> 2)) * NPROJ + C_DV + h * 128 + 32 * (wid >> 2) + 8 * (lane & 3);
    const int vlane = ((lane >> 4) & 1) * 32 + (lane & 3) * 8 + (4 * hi + ((lane & 15) >> 2)) * 64;
    const int klane = (r32 >> 3) * 1024 + (r32 & 7) * 128 + ((hi ^ (r32 & 7)) << 4);
    bf16x8 qf[4];
    { const bf16* qrow = PROJ + (rowbase + q0 + r32) * NPROJ + C_DQ + h * 128 + m * 64 + hi * 8;
#pragma unroll
      for (int d0 = 0; d0 < 4; ++d0) qf[d0] = *(const bf16x8*)(qrow + d0 * 16); }
    const bf16* ksrc = kvb + (size_t)(8 * wid + (lane >> 3)) * NPROJ + C_DK + h * 128 + m * 64 + 8 * ((lane & 7) ^ (lane >> 3));
    f32x16 oa[4];
#pragma unroll
    for (int i = 0; i < 4; ++i) oa[i] = f32x16{};
    float ls = 0.f;
    const int n = t_hi - t_lo;
    const int tq = q0 >> 6;
    const unsigned ldsb = (unsigned)(uintptr_t)lds;
    const float dq0 = (float)(q0 + r32 - t_lo * 64 - 4 * hi);
#define DMA_K(i, slot) glds16a(ksrc + (size_t)min(t_lo + (i), SEQ / 64 - 1) * 64 * NPROJ, (unsigned)__builtin_amdgcn_readfirstlane((int)(ldsb + (slot) * 8192 + wid * 1024)))
#define DMA_V(i, slot) do { const bf16* v_ = vsrc + (size_t)min(t_lo + (i), SEQ / 64 - 1) * 64 * NPROJ; const unsigned d_ = (unsigned)__builtin_amdgcn_readfirstlane((int)(ldsb + 24576 + (slot) * 16384 + wid * 1024)); glds16a(v_, d_); glds16a(v_ + 64, d_ + 8192); } while (0)
#define KADDR(p, d0) ((const LAS unsigned char*)(uintptr_t)((unsigned)(uintptr_t)(p) ^ (unsigned)((d0) << 5)))
#define BIAS(S0, S1, i) do { const float dq_ = dq0 - 64.0f * (float)(i); _Pragma("unroll") for (int r = 0; r < 16; ++r) { const float c = (float)((r & 3) + 8 * (r >> 2)); \
        S0[r] = nslope2 * fabsf(dq_ - c) - B2; S1[r] = nslope2 * fabsf(dq_ - (c + 32.0f)) - B2; } } while (0)
#define QK_ACC(S0, S1, slot) do { const LAS unsigned char* kp_ = lds + (slot) * 8192 + klane; _Pragma("unroll") for (int d0 = 0; d0 < 4; ++d0) { \
        const LAS unsigned char* ka_ = KADDR(kp_, d0); const bf16x8 b0 = *(const LAS bf16x8*)(ka_); const bf16x8 b1 = *(const LAS bf16x8*)(ka_ + 4096); \
        S0 = MFMA32(b0, qf[d0], S0); S1 = MFMA32(b1, qf[d0], S1); } } while (0)
#define FENCE() __builtin_amdgcn_sched_barrier(0)
#define EXP4(C, k, s_) do { C[k] = __builtin_amdgcn_exp2f(C[k]); C[(k) + 1] = __builtin_amdgcn_exp2f(C[(k) + 1]); C[(k) + 2] = __builtin_amdgcn_exp2f(C[(k) + 2]); C[(k) + 3] = __builtin_amdgcn_exp2f(C[(k) + 3]); \
        s_ += (C[k] + C[(k) + 1]) + (C[(k) + 2] + C[(k) + 3]); } while (0)
#define PACK8(C, k) (u32x4){pk2(C[k], C[(k) + 1]), pk2(C[(k) + 2], C[(k) + 3]), pk2(C[(k) + 4], C[(k) + 5]), pk2(C[(k) + 6], C[(k) + 7])}
#define KLD(dst0, dst1, d0) do { const LAS unsigned char* ka_ = KADDR(kp_, d0); dst0 = *(const LAS bf16x8*)(ka_); dst1 = *(const LAS bf16x8*)(ka_ + 4096); } while (0)
#define VLD(dst, off) dst = cat8(vtr(vb_ + (off)), vtr(vb_ + (off) + 512))
#define BIAS4(S0, S1, k, dq_) do { if (strad_) { _Pragma("unroll") for (int r = (k); r < (k) + 4; ++r) { const float c = (float)((r & 3) + 8 * (r >> 2)); \
        S0[r] = nslope2 * fabsf(dq_ - c) - B2; S1[r] = nslope2 * fabsf(dq_ - (c + 32.0f)) - B2; } } \
      else { BIAS4F_##k(S0, S1); } } while (0)
#define FMK(dst, base, K) do { float t_; asm("v_fmamk_f32 %0, %1, " #K ", %2" : "=v"(t_) : "v"(sg_), "v"(base)); dst = t_; } while (0)
#define BIAS4F_0(S0, S1) do { FMK(S0[0], base0_, 0x00000000); FMK(S1[0], base1_, 0x00000000); FMK(S0[1], base0_, 0x3f800000); FMK(S1[1], base1_, 0x3f800000); FMK(S0[2], base0_, 0x40000000); FMK(S1[2], base1_, 0x40000000); FMK(S0[3], base0_, 0x40400000); FMK(S1[3], base1_, 0x40400000); } while (0)
#define BIAS4F_4(S0, S1) do { FMK(S0[4], base0_, 0x41000000); FMK(S1[4], base1_, 0x41000000); FMK(S0[5], base0_, 0x41100000); FMK(S1[5], base1_, 0x41100000); FMK(S0[6], base0_, 0x41200000); FMK(S1[6], base1_, 0x41200000); FMK(S0[7], base0_, 0x41300000); FMK(S1[7], base1_, 0x41300000); } while (0)
#define BIAS4F_8(S0, S1) do { FMK(S0[8], base0_, 0x41800000); FMK(S1[8], base1_, 0x41800000); FMK(S0[9], base0_, 0x41880000); FMK(S1[9], base1_, 0x41880000); FMK(S0[10], base0_, 0x41900000); FMK(S1[10], base1_, 0x41900000); FMK(S0[11], base0_, 0x41980000); FMK(S1[11], base1_, 0x41980000); } while (0)
#define BIAS4F_12(S0, S1) do { FMK(S0[12], base0_, 0x41c00000); FMK(S1[12], base1_, 0x41c00000); FMK(S0[13], base0_, 0x41c80000); FMK(S1[13], base1_, 0x41c80000); FMK(S0[14], base0_, 0x41d00000); FMK(S1[14], base1_, 0x41d00000); FMK(S0[15], base0_, 0x41d80000); FMK(S1[15], base1_, 0x41d80000); } while (0)
#define STEP(C0, C1, N0, N1, i) do { \
        DMA_K((i) + 3, r0); DMA_V((i) + 2, r2);     \
        const LAS unsigned char* kp_ = lds + r1 * 8192 + klane; \
        const LAS unsigned char* vb_ = lds + 24576 + r0 * 16384 + vlane; \
        const float dq2_ = dq0 - 64.0f * (float)((i) + 2); \
        const int tt_ = t_lo + (i) + 2; const bool strad_ = (tt_ == tq); const float sg_ = (tt_ < tq) ? slope2 : nslope2; const float base0_ = -sg_ * dq2_ - B2, base1_ = base0_ + 32.0f * sg_; \
        float s_ = 0.f; bf16x8 ka0, ka1, va, vb2, vc, vd; u32x4 pw0, pw1, pw2, pw3; \
        KLD(ka0, ka1, 0); \
        FENCE(); \
          \
        N0 = MFMA32(ka0, qf[0], N0); N1 = MFMA32(ka1, qf[0], N1); KLD(ka0, ka1, 1); EXP4(C0, 0, s_); FENCE(); \
        N0 = MFMA32(ka0, qf[1], N0); N1 = MFMA32(ka1, qf[1], N1); KLD(ka0, ka1, 2); EXP4(C0, 4, s_); pw0 = PACK8(C0, 0); FENCE(); \
        N0 = MFMA32(ka0, qf[2], N0); N1 = MFMA32(ka1, qf[2], N1); KLD(ka0, ka1, 3); EXP4(C0, 8, s_); FENCE(); \
        N0 = MFMA32(ka0, qf[3], N0); N1 = MFMA32(ka1, qf[3], N1); VLD(va, 0); VLD(vb2, 4096); EXP4(C0, 12, s_); pw1 = PACK8(C0, 8); FENCE(); \
          \
        VLD(vc, 8192); VLD(vd, 12288); oa[0] = MFMA32(__builtin_bit_cast(bf16x8, pw0), va, oa[0]); oa[1] = MFMA32(__builtin_bit_cast(bf16x8, pw0), vb2, oa[1]); EXP4(C1, 0, s_); FENCE(); \
        VLD(va, 1024); VLD(vb2, 5120); oa[2] = MFMA32(__builtin_bit_cast(bf16x8, pw0), vc, oa[2]); oa[3] = MFMA32(__builtin_bit_cast(bf16x8, pw0), vd, oa[3]); EXP4(C1, 4, s_); pw2 = PACK8(C1, 0); FENCE(); \
        VLD(vc, 9216); VLD(vd, 13312); oa[0] = MFMA32(__builtin_bit_cast(bf16x8, pw1), va, oa[0]); oa[1] = MFMA32(__builtin_bit_cast(bf16x8, pw1), vb2, oa[1]); EXP4(C1, 8, s_); FENCE(); \
        VLD(va, 2048); VLD(vb2, 6144); oa[2] = MFMA32(__builtin_bit_cast(bf16x8, pw1), vc, oa[2]); oa[3] = MFMA32(__builtin_bit_cast(bf16x8, pw1), vd, oa[3]); EXP4(C1, 12, s_); pw3 = PACK8(C1, 8); FENCE(); \
        ls += s_; \
        VLD(vc, 10240); VLD(vd, 14336); oa[0] = MFMA32(__builtin_bit_cast(bf16x8, pw2), va, oa[0]); oa[1] = MFMA32(__builtin_bit_cast(bf16x8, pw2), vb2, oa[1]); BIAS4(C0, C1, 0, dq2_); FENCE(); \
        VLD(va, 3072); VLD(vb2, 7168); oa[2] = MFMA32(__builtin_bit_cast(bf16x8, pw2), vc, oa[2]); oa[3] = MFMA32(__builtin_bit_cast(bf16x8, pw2), vd, oa[3]); BIAS4(C0, C1, 4, dq2_); FENCE(); \
        VLD(vc, 11264); VLD(vd, 15360); oa[0] = MFMA32(__builtin_bit_cast(bf16x8, pw3), va, oa[0]); oa[1] = MFMA32(__builtin_bit_cast(bf16x8, pw3), vb2, oa[1]); BIAS4(C0, C1, 8, dq2_); FENCE(); \
        oa[2] = MFMA32(__builtin_bit_cast(bf16x8, pw3), vc, oa[2]); oa[3] = MFMA32(__builtin_bit_cast(bf16x8, pw3), vd, oa[3]); BIAS4(C0, C1, 12, dq2_); FENCE(); \
        asm volatile("s_waitcnt vmcnt(3)" ::: "memory"); \
        __syncthreads(); { const int t_ = r0; r0 = r1; r1 = r2; r2 = t_; } } while (0)
    f32x16 A0, A1, B0, B1;
    if (wid >= 4) __builtin_amdgcn_s_setprio(1);
    int r0 = 0, r1 = 1, r2 = 2;
    DMA_K(0, 0); DMA_V(0, 0); DMA_K(1, 1); DMA_V(1, 1); DMA_K(2, 2);
    BIAS(A0, A1, 0);
    VMWAIT0(); __syncthreads();
    { const LAS unsigned char* kp_ = lds + klane; _Pragma("unroll") for (int d0 = 0; d0 < 4; ++d0) {
        const LAS unsigned char* ka_ = KADDR(kp_, d0); const bf16x8 b0 = *(const LAS bf16x8*)(ka_); const bf16x8 b1 = *(const LAS bf16x8*)(ka_ + 4096);
        A0 = MFMA32(b0, qf[d0], A0); A1 = MFMA32(b1, qf[d0], A1); } }
    BIAS(B0, B1, 1);
    asm volatile("s_waitcnt lgkmcnt(0)" ::: "memory"); __syncthreads();
#pragma unroll 1
    for (int i = 0;; i += 2) {
        STEP(A0, A1, B0, B1, i);
        if (i + 1 >= n) break;
        STEP(B0, B1, A0, A1, i + 1);
        if (i + 2 >= n) break;
    }
    VMWAIT0();
    __builtin_amdgcn_s_setprio(0);
#undef DMA_K
#undef DMA_V
#undef BIAS
#undef QK_ACC
#undef KADDR
#undef STEP
#undef FENCE
#undef EXP4
#undef PACK8
#undef KLD
#undef VLD
#undef BIAS4
    ls += __shfl_xor(ls, 32);
    int le = lane; asm volatile("" : "+v"(le));
    const int r32e = le & 31, hie = le >> 5;
    if (hie == 0) wsf[r32e] = 1.0f / ls;
    asm volatile("s_waitcnt lgkmcnt(0)" ::: "memory");
#pragma unroll
    for (int r = 0; r < 16; ++r) {
        const int qr = crow(r, hie); const float a1 = wsf[qr];
        bf16* orow = OB + (rowbase + q0 + qr) * 512 + h * 128 + r32e;
#pragma unroll
        for (int db = 0; db < 4; ++db) orow[32 * db] = (bf16)(pk2(oa[db][r] * a1, 0.f) & 0xffffu);
        asm volatile("" ::: "memory");
    }
    __syncthreads();
}
__device__ __forceinline__ void attn_combine(Frame& F, const Args& A, int l) {
    const bf16* OB0 = (const bf16*)((unsigned char*)F.out + 32 * MiB); const bf16* OB1 = OB0 + (size_t)M * 512; bf16* MIX = (bf16*)(F.ws + WS_MIX);
    const Params* P = (const Params*)(F.ws + WS_CTL + PAR_OFF);
    const float lam = P->lam[l], post = 1.0f - (0.8f - 0.6f * expf(-0.3f * (float)l));
    const int c16 = F.tid & 15, grp = F.tid >> 4;
    float g8[8];
#pragma unroll
    for (int i = 0; i < 8; ++i) g8[i] = A.in[12][l * 128 + 8 * c16 + i] * post;
    for (int it0 = F.vcu; it0 < M * 4 / 32; it0 += 4 * F.G) {
        u32x4 av[4], bv[4];
#pragma unroll
        for (int q = 0; q < 4; ++q) { const int it = it0 + q * F.G; if (it < M * 4 / 32) { const int gi = it * 32 + grp; const size_t off = (size_t)(gi >> 2) * 512 + (gi & 3) * 128 + 8 * c16;
            av[q] = *(const u32x4*)(OB0 + off); bv[q] = *(const u32x4*)(OB1 + off); } }
#pragma unroll
        for (int q = 0; q < 4; ++q) { const int it = it0 + q * F.G; if (it < M * 4 / 32) {
            const int gi = it * 32 + grp, row = gi >> 2, h = gi & 3;
            const u32x4 a = av[q], bq = bv[q];
            float v[8] = {bflo(a.x) - lam * bflo(bq.x), bfhi(a.x) - lam * bfhi(bq.x), bflo(a.y) - lam * bflo(bq.y), bfhi(a.y) - lam * bfhi(bq.y),
                          bflo(a.z) - lam * bflo(bq.z), bfhi(a.z) - lam * bfhi(bq.z), bflo(a.w) - lam * bflo(bq.w), bfhi(a.w) - lam * bfhi(bq.w)};
            float ss = 0.f;
#pragma unroll
            for (int i = 0; i < 8; ++i) ss += v[i] * v[i];
            ss += __shfl_xor(ss, 1); ss += __shfl_xor(ss, 2); ss += __shfl_xor(ss, 4); ss += __shfl_xor(ss, 8);
            const float rs = __builtin_amdgcn_rsqf(ss * (1.0f / 128.0f) + EPS);
            u32x4 o; o.x = pk2(v[0] * rs * g8[0], v[1] * rs * g8[1]); o.y = pk2(v[2] * rs * g8[2], v[3] * rs * g8[3]); o.z = pk2(v[4] * rs * g8[4], v[5] * rs * g8[5]); o.w = pk2(v[6] * rs * g8[6], v[7] * rs * g8[7]);
            *(u32x4*)(MIX + (size_t)row * DM + 512 + h * 128 + 8 * c16) = o; } }
    }
}

__device__ __forceinline__ void ret_out_pair(Frame& F, const Args& A, int l, int pair) {
    const bf16* PROJ = (const bf16*)(F.ws + WS_PROJ); bf16* MIX = (bf16*)(F.ws + WS_MIX);
    int lane = F.lane; asm volatile("" : "+v"(lane));
    const int r32 = lane & 31, hi = lane >> 5, grp = F.wave >> 2, wq = F.wave & 3, gt = (wq << 6) | lane;
    const int item = 2 * pair + grp; const int n = item & 63, h = (item >> 6) & 7, b = item >> 9;
    const float lgf2 = -expf(A.in[3][l * RH + h]) * LOG2E, lgb2 = -expf(A.in[4][l * RH + h]) * LOG2E;
    const size_t row0 = (size_t)b * SEQ + (size_t)n * CH;
    LAS unsigned char* LK = F.lds + grp * 49152; LAS unsigned char* LV = LK + 16384; LAS unsigned char* LRF = LK + 32768; LAS unsigned char* LRB = LK + 40960;
    const bf16* RF = (const bf16*)(F.ws + WS_RF) + (size_t)item * 4096; const bf16* RB = (const bf16*)(F.ws + WS_RB) + (size_t)item * 4096;
#pragma unroll
    for (int i = 0; i < 4; ++i) { const int pc = gt + 256 * i, s = pc >> 3, ch = pc & 7;
        *(LAS u32x4*)(LV + s * 128 + ch * 16) = *(const u32x4*)(PROJ + (row0 + s) * NPROJ + C_RV + h * 64 + 8 * ch);
        *(LAS u32x4*)(LK + s * 128 + ((ch ^ (s & 7)) << 4)) = *(const u32x4*)(PROJ + (row0 + s) * NPROJ + C_RK + h * 64 + 8 * ch); }
#pragma unroll
    for (int i = 0; i < 2; ++i) { const int pc = gt + 256 * i;
        *(LAS u32x4*)(LRF + pc * 16) = *(const u32x4*)(RF + pc * 8); *(LAS u32x4*)(LRB + pc * 16) = *(const u32x4*)(RB + pc * 8); }
    const int t0 = 32 * wq;
    LAS unsigned char* GW = F.lds + 98304 + F.wave * 4096;
#pragma unroll
    for (int i = 0; i < 4; ++i) { const int pc = lane + 64 * i, rw = pc >> 3, ch = pc & 7;
        *(LAS u32x4*)(GW + rw * 128 + ch * 16) = *(const u32x4*)(PROJ + (row0 + t0 + rw) * NPROJ + C_RG + h * 64 + 8 * ch); }
    bf16x8 qf[4];
    { const bf16* qrow = PROJ + (row0 + t0 + r32) * NPROJ + C_RQ + h * 64 + hi * 8;
#pragma unroll
      for (int d0 = 0; d0 < 4; ++d0) qf[d0] = *(const bf16x8*)(qrow + d0 * 16); }
    __syncthreads();
    f32x16 X[4];
    const unsigned kb0 = (unsigned)(uintptr_t)LK + (unsigned)(r32 * 128 + ((hi ^ (r32 & 7)) << 4));
#pragma unroll
    for (int sb = 0; sb < 4; ++sb) { X[sb] = f32x16{};
#pragma unroll
        for (int d0 = 0; d0 < 4; ++d0) { const bf16x8 kf = *(const LAS bf16x8*)(uintptr_t)((kb0 + sb * 4096) ^ (unsigned)(d0 << 5)); X[sb] = MFMA32(kf, qf[d0], X[sb]); } }
    u32x4 pw[8];
    const float tf = (float)(t0 + r32);
#pragma unroll
    for (int sb = 0; sb < 4; ++sb) {
#pragma unroll
        for (int r = 0; r < 16; ++r) { const float dl = tf - (float)(32 * sb + crow(r, hi)); const float e = lgf2 * fmaxf(dl, 0.f) + lgb2 * fmaxf(-dl, 0.f); X[sb][r] *= __builtin_amdgcn_exp2f(e - 3.0f); }
        pw[2 * sb] = (u32x4){pk2(X[sb][0], X[sb][1]), pk2(X[sb][2], X[sb][3]), pk2(X[sb][4], X[sb][5]), pk2(X[sb][6], X[sb][7])};
        pw[2 * sb + 1] = (u32x4){pk2(X[sb][8], X[sb][9]), pk2(X[sb][10], X[sb][11]), pk2(X[sb][12], X[sb][13]), pk2(X[sb][14], X[sb][15])};
    }
    __builtin_amdgcn_sched_barrier(0);
    const int q4 = (lane & 15) >> 2, tcol = 32 * ((lane >> 4) & 1) + 8 * (lane & 3);
    const LAS unsigned char* pv = LV + (4 * hi + q4) * 128 + tcol;
    const LAS unsigned char* prf = LRF + (8 * hi + q4) * 128 + tcol;
    const LAS unsigned char* prb = LRB + (8 * hi + q4) * 128 + tcol;
    f32x16 aI[2], aF[2], aB[2];
#pragma unroll
    for (int eb = 0; eb < 2; ++eb) { aI[eb] = f32x16{};
#pragma unroll
        for (int ks = 0; ks < 8; ++ks) {
            const bf16x8 vf = cat8(vtr(pv + ks * 2048 + 64 * eb), vtr(pv + ks * 2048 + 1024 + 64 * eb));
            aI[eb] = MFMA32(__builtin_bit_cast(bf16x8, pw[ks]), vf, aI[eb]); } }
    __builtin_amdgcn_sched_barrier(0);
#pragma unroll
    for (int eb = 0; eb < 2; ++eb) { aF[eb] = f32x16{}; aB[eb] = f32x16{};
#pragma unroll
        for (int d0 = 0; d0 < 4; ++d0) {
            const bf16x8 rf = cat8(vtr(prf + d0 * 2048 + 64 * eb), vtr(prf + d0 * 2048 + 512 + 64 * eb));
            const bf16x8 rb = cat8(vtr(prb + d0 * 2048 + 64 * eb), vtr(prb + d0 * 2048 + 512 + 64 * eb));
            aF[eb] = MFMA32(qf[d0], rf, aF[eb]); aB[eb] = MFMA32(qf[d0], rb, aB[eb]); } }
    __builtin_amdgcn_sched_barrier(0);
    const float* rng = A.in[5] + l * 64; const float g0 = rng[r32], g1 = rng[32 + r32];
#pragma unroll
    for (int r = 0; r < 16; ++r) {
        const int tl = t0 + crow(r, hi);
        const float wf = __builtin_amdgcn_exp2f(lgf2 * (float)(tl + 1)), wb = __builtin_amdgcn_exp2f(lgb2 * (float)(CH - tl));
        const float v0 = aI[0][r] + wf * aF[0][r] + wb * aB[0][r], v1 = aI[1][r] + wf * aF[1][r] + wb * aB[1][r];
        const float ss = half_sum32(v0 * v0 + v1 * v1); const float rs = __builtin_amdgcn_rsqf(ss * (1.0f / 64.0f) + EPS);
        const LAS unsigned short* grow = (const LAS unsigned short*)(GW + crow(r, hi) * 128) + r32;
        const float ga = bf2f(grow[0]), gb = bf2f(grow[32]);
        const float sa = ga * __builtin_amdgcn_rcpf(1.0f + __builtin_amdgcn_exp2f(-LOG2E * ga)), sb2 = gb * __builtin_amdgcn_rcpf(1.0f + __builtin_amdgcn_exp2f(-LOG2E * gb));
        LAS unsigned short* orow = (LAS unsigned short*)(GW + crow(r, hi) * 128) + r32;
        orow[0] = (unsigned short)(pk2(v0 * rs * g0 * sa, 0.f) & 0xffffu); orow[32] = (unsigned short)(pk2(v1 * rs * g1 * sb2, 0.f) & 0xffffu);
    }
    asm volatile("s_waitcnt lgkmcnt(0)" ::: "memory");
#pragma unroll
    for (int i = 0; i < 4; ++i) { const int pc = lane + 64 * i, rw = pc >> 3, ch = pc & 7;
        *(u32x4*)(MIX + (row0 + t0 + rw) * DM + h * 64 + 8 * ch) = *(const LAS u32x4*)(GW + rw * 128 + ch * 16); }
    __syncthreads();
}

#define XB_TMO      128
#define XB_XCNT(j)  (256  + 64 * (j))
#define XB_XSUB(j)  (1280 + 64 * (j))
#define XB_XGEN(j)  (2304 + 64 * (j))
#define XB_TOP      3328
#define XB_TOPGEN   3392
#define XCD_BAR_WORDS 3456
#define XB_SPIN_CAP (1u << 18)

__device__ __forceinline__ unsigned xb_ld(unsigned* p)              { return __hip_atomic_load(p, __ATOMIC_RELAXED, __HIP_MEMORY_SCOPE_AGENT); }
__device__ __forceinline__ unsigned xb_add(unsigned* p, unsigned v) { return __hip_atomic_fetch_add(p, v, __ATOMIC_RELAXED, __HIP_MEMORY_SCOPE_AGENT); }
__device__ __forceinline__ unsigned xb_xcc_id() { return (unsigned)__builtin_amdgcn_s_getreg((3 << 11) | 20) & 0xFu; }
#define XB_SPIN(cond, bar) do { unsigned _sp = 0; while (cond) { __builtin_amdgcn_s_sleep(1); \
    if ((++_sp & 255u) == 0u) { if (xb_ld(&(bar)[XB_TMO])) break; if (_sp > XB_SPIN_CAP) { atomicAdd(&(bar)[XB_TMO], 1u); break; } } } } while (0)

struct XcdBarrier {
    unsigned* bar; unsigned x;
    volatile LAS unsigned* st;
};

__device__ __forceinline__ XcdBarrier xcd_barrier_post(unsigned* bar, volatile LAS unsigned* st) {
    XcdBarrier b; b.bar = bar; b.x = xb_xcc_id(); b.st = st;
    if (threadIdx.x == 0) (void)xb_add(&bar[XB_XCNT(b.x)], 1u);
    return b;
}
__device__ __forceinline__ void xcd_barrier_complete(unsigned* bar, unsigned x, unsigned& nloc, unsigned& nx) {
    const unsigned G = gridDim.x * gridDim.y * gridDim.z;
    unsigned sum, cnt, mine, sp = 0u;
    for (;;) {
        sum = 0u; cnt = 0u; mine = 0u;
#pragma unroll
        for (unsigned j = 0; j < 16; ++j) { const unsigned c = xb_ld(&bar[XB_XCNT(j)]); sum += c; cnt += (c > 0u) ? 1u : 0u; mine = (j == x) ? c : mine; }
        if (sum == G) break;
        __builtin_amdgcn_s_sleep(1);
        if ((++sp & 255u) == 0u) { if (xb_ld(&bar[XB_TMO])) break; if (sp > XB_SPIN_CAP) { atomicAdd(&bar[XB_TMO], 1u); break; } }
    }
    nloc = mine > 0u ? mine : 1u; nx = cnt > 0u ? cnt : 1u;
}

__device__ __forceinline__ void xcd_barrier(const XcdBarrier& b) {
    asm volatile("s_waitcnt vmcnt(0)" ::: "memory");
    __syncthreads();
    if (threadIdx.x == 0) {
        unsigned* bar = b.bar;
        __builtin_amdgcn_s_waitcnt(0);
        unsigned nloc = b.st[0], nx = b.st[1];
        if (nloc == 0u) { xcd_barrier_complete(bar, b.x, nloc, nx); b.st[0] = nloc; b.st[1] = nx; }
        const unsigned old = xb_add(&bar[XB_XSUB(b.x)], 1u);
        const unsigned gen = old / nloc;
        if (old + 1u == (gen + 1u) * nloc) {
            __builtin_amdgcn_fence(__ATOMIC_RELEASE, "agent");
            asm volatile("s_waitcnt vmcnt(0)" ::: "memory");
            const unsigned og = xb_add(&bar[XB_TOP], 1u);
            const unsigned tg = og / nx;
            if (og + 1u == (tg + 1u) * nx) xb_add(&bar[XB_TOPGEN], 1u);
            else XB_SPIN(xb_ld(&bar[XB_TOPGEN]) == tg, bar);
            __builtin_amdgcn_fence(__ATOMIC_ACQUIRE, "agent");
            xb_add(&bar[XB_XGEN(b.x)], 1u);
            asm volatile("s_waitcnt vmcnt(0)" ::: "memory");
        } else {
            XB_SPIN(xb_ld(&bar[XB_XGEN(b.x)]) == gen, bar);
            __builtin_amdgcn_fence(__ATOMIC_ACQUIRE, "agent");
            asm volatile("s_waitcnt vmcnt(0)" ::: "memory");
        }
    }
    __syncthreads();
}

constexpr int N_PHASES = 1 + 7 * DEPTH;

__global__ void __launch_bounds__(NWAVES * 64, 2) fwd_megakernel(Args args) {
    extern __shared__ __attribute__((aligned(1024))) unsigned char lds_raw[];
    cg::grid_group grid = cg::this_grid();
    Frame F0;
    F0.lds = (LAS unsigned char*)lds_raw;
    F0.tid = threadIdx.x; F0.lane = F0.tid & 63; F0.wave = __builtin_amdgcn_readfirstlane(F0.tid >> 6);
    F0.G = gridDim.x; { const int bx0 = blockIdx.x; F0.vcu = (F0.G % 8 == 0) ? (bx0 % 8) * (F0.G / 8) + bx0 / 8 : bx0; }
    F0.out = args.out; F0.ws = args.ws;
    const int lo = args.ph_lo, hi = args.ph_hi;
    for (int u = threadIdx.x; u < 64; u += NWAVES * 64) ((LAS unsigned*)(F0.lds + LDS_MISC))[u] = 0u;
    __syncthreads();
    (void)xcd_barrier_post((unsigned*)(args.ws + WS_CTL + BAR_OFF), (volatile LAS unsigned*)(F0.lds + LDS_MISC) + 8);
#define IN(k) (lo <= (k) && (k) < hi)
    if (lo < 0) grid.sync();
#define xcd_seam() do { if (IN(pb + 3)) { unsigned char* w_ = args.ws; asm volatile("" : "+s"(w_)); XcdBarrier b_; b_.bar = (unsigned*)(w_ + WS_CTL + BAR_OFF); b_.x = xb_xcc_id(); b_.st = (volatile LAS unsigned*)(F0.lds + LDS_MISC) + 8; xcd_barrier(b_); } } while (0)
#define SEAM(k) do { if (IN(k) && IN((k) + 1)) { unsigned char* w_ = args.ws; asm volatile("" : "+s"(w_)); XcdBarrier b_; b_.bar = (unsigned*)(w_ + WS_CTL + BAR_OFF); b_.x = xb_xcc_id(); b_.st = (volatile LAS unsigned*)(F0.lds + LDS_MISC) + 8; xcd_barrier(b_); } } while (0)
#define PH_BEGIN() Frame F = F0; int bx = (int)blockIdx.x; asm volatile("" : "+s"(F.ws), "+s"(F.out), "+s"(F.G), "+s"(F.vcu), "+s"(bx), "+s"(F.wave), "+v"(F.lane)); F.tid = (F.wave << 6) | F.lane; \
    float* SSQ = (float*)(F.ws + WS_CTL); bf16* XB = (bf16*)(F.ws + WS_XB); bf16* PROJ = (bf16*)(F.ws + WS_PROJ); bf16* MIX = (bf16*)(F.ws + WS_MIX); bf16* HID = (bf16*)(F.ws + WS_HID); \
    (void)SSQ; (void)XB; (void)PROJ; (void)MIX; (void)HID; (void)bx;
#ifndef SKIP_P0
    if (IN(0)) { PH_BEGIN(); p0_prologue(F, args); }
#endif
    SEAM(0);
#pragma unroll
    for (int l = 0; l < DEPTH; ++l) {
        const int pb = 1 + 7 * l;
#ifndef SKIP_G1
        if (IN(pb)) {
            PH_BEGIN();
            pg8::Gemm g{XB, (const bf16*)(F.ws + WS_WIN) + (size_t)l * NPROJ * DM, M, NPROJ, DM}; pg8::StaticOrder S; S.init(M, NPROJ, F.G, bx, WGM_IN);
            pg8::EpiProj E{PROJ, NPROJ, SSQ + (size_t)(2 * l) * M};
            pg8::gemm_phase<pg8::EpiProj, pg8::StaticOrder, true, true>(F.lds, g, S, E, F.tid);
        }
#endif
        SEAM(pb);
        if (IN(pb + 1)) {
            PH_BEGIN();
#ifndef SKIP_RKV
            for (int it = F.vcu; it < BATCH * RH * NCH; it += F.G) ret_kv_item(F, args, l, it);
#endif
            qknorm_pass(F, args, l);
        } SEAM(pb + 1);
        if (IN(pb + 2)) { PH_BEGIN(); ret_scan(F, args, l); } SEAM(pb + 2);
        if (IN(pb + 3)) {
            PH_BEGIN();
#pragma unroll 1
            for (int it = F.vcu; it < 512; it += F.G) {
                const int k = it >> 8, v = it & 255, x = v >> 5, j = v & 31, bb = (x >> 1) & 1, mm = x >> 2;
                const int hh = k == 0 ? 3 - (x & 1) : ((x & 1) ? 1 : 0), qq = (k == 1 && (x & 1)) ? ((j + 16) & 31) : j;
                attn_half(F, args, l, bb, hh, qq, mm);
            }
            {
                const bool g256 = (F.G == 256); const bool take = g256 ? !((F.vcu >> 5) & 1) : true;
                const int rs = g256 ? ((F.vcu >> 6) * 32 + (F.vcu & 31)) : F.vcu, rstride = g256 ? 128 : F.G;
                if (take) {
#pragma unroll 1
                    for (int pr = rs; pr < BATCH * RH * NCH / 2; pr += rstride) ret_out_pair(F, args, l, pr);
                }
            }
        } xcd_seam();
        if (IN(pb + 3)) { PH_BEGIN(); attn_combine(F, args, l); }
        SEAM(pb + 3);
#ifndef SKIP_G2
        if (IN(pb + 4)) {
            PH_BEGIN();
            pg8::Gemm g{MIX, (const bf16*)(F.ws + WS_WOUT) + (size_t)l * DM * DM, M, DM, DM}; pg8::StaticOrder S; S.init(M, DM, F.G, bx, WGM_SQ);
            pg8::EpiRes E{XB, nullptr, SSQ + (size_t)(2 * l + 1) * M};
            pg8::gemm_phase<pg8::EpiRes, pg8::StaticOrder, true, true>(F.lds, g, S, E, F.tid);
        }
#endif
        SEAM(pb + 4);
#ifndef SKIP_G3
        if (IN(pb + 5)) {
            PH_BEGIN();
            pg8::Gemm g{XB, (const bf16*)(F.ws + WS_WGU) + (size_t)l * NGU * DM, M, NGU, DM}; pg8::StaticOrder S; S.init(M, NGU, F.G, bx, WGM_GU);
            pg8::EpiSwiglu E{HID, FF, SSQ + (size_t)(2 * l + 1) * M};
            pg8::gemm_phase<pg8::EpiSwiglu, pg8::StaticOrder, true, true>(F.lds, g, S, E, F.tid);
        }
#endif
        SEAM(pb + 5);
#ifndef SKIP_G4
        if (IN(pb + 6)) {
            PH_BEGIN();
            pg8::Gemm g{HID, (const bf16*)(F.ws + WS_WDN) + (size_t)l * DM * FF, M, DM, FF}; pg8::StaticOrder S; S.init(M, DM, F.G, bx, WGM_SQ);
            const bool last = (l == DEPTH - 1);
            pg8::EpiRes E{XB, last ? F.out : nullptr, SSQ + (size_t)(2 * l + 2 < 4 ? 2 * l + 2 : 0) * M};
            pg8::gemm_phase<pg8::EpiRes, pg8::StaticOrder, true, true>(F.lds, g, S, E, F.tid);
        }
#endif
        SEAM(pb + 6);
    }
#undef IN
#undef SEAM
}

#ifndef MK_N_LAUNCHES
#define MK_N_LAUNCHES 1
#endif
extern "C" void kernel_launch(void* const* d_in, const int* in_sizes, int n_in, void* d_out, int out_size, void* d_ws, size_t ws_size, hipStream_t stream) {
    static int grid = 0;
    if (grid == 0) {
        if (n_in != 18 || out_size != M * DM || ws_size < WS_END) { fprintf(stderr, "kernel_launch: unexpected shapes (n_in %d out %d ws %zu)\n", n_in, out_size, ws_size); grid = -1; return; }
        int dev = 0, cus = 0, per_cu = 0;
        hipGetDevice(&dev); hipDeviceGetAttribute(&cus, hipDeviceAttributeMultiprocessorCount, dev);
        if (hipFuncSetAttribute((const void*)fwd_megakernel, hipFuncAttributeMaxDynamicSharedMemorySize, LDS_BYTES) != hipSuccess) { fprintf(stderr, "kernel_launch: hipFuncSetAttribute failed\n"); grid = -1; return; }
        if (hipOccupancyMaxActiveBlocksPerMultiprocessor(&per_cu, (const void*)fwd_megakernel, NWAVES * 64, LDS_BYTES) != hipSuccess || per_cu < 1) { fprintf(stderr, "kernel_launch: occupancy query failed (%d)\n", per_cu); (void)hipGetLastError(); per_cu = 1; }
        grid = cus * per_cu;
    }
    if (grid < 0) return;
    hipMemsetAsync((char*)d_ws + WS_CTL, 0, CTL_BYTES, stream);
    Args a{};
    for (int i = 0; i < 18; ++i) a.in[i] = (const float*)d_in[i];
    a.out = (float*)d_out; a.ws = (unsigned char*)d_ws;
    const int nl = MK_N_LAUNCHES;
    for (int li = 0; li < nl; ++li) {
        a.ph_lo = (nl == 1) ? 0 : li; a.ph_hi = (nl == 1) ? N_PHASES : li + 1;
        void* kargs[] = {&a};
        hipError_t e = hipLaunchCooperativeKernel((const void*)fwd_megakernel, dim3(grid), dim3(NWAVES * 64), kargs, LDS_BYTES, stream);
        if (e != hipSuccess) { fprintf(stderr, "kernel_launch: cooperative launch %d failed: %s (grid %d)\n", li, hipGetErrorString(e), grid); break; }
    }
}
```
